# Optimizing an MI355X kernel written in HIP

```python
import jax, jax.numpy as jnp
from jax import lax
import numpy as np

D_MODEL = 1024
BATCH = 2
SEQ = 16384
DEPTH = 1
DEC_BATCH = 16
DEC_SEQ = 4096
PAST_LEN = 128

D_MIX = D_MODEL
D_RWKV = D_MIX // 2
D_ATTN = D_MIX - D_RWKV
RWKV_HEAD = 64
N_RWKV_HEADS = D_RWKV // RWKV_HEAD
ATTN_HEAD = 64
N_ATTN_HEADS = D_ATTN // ATTN_HEAD
DECAY_LORA = 64
ICLR_LORA = 64
RWKV_COLS = 4 * D_RWKV + DECAY_LORA + ICLR_LORA
ATTN_COLS = 4 * D_ATTN
D_IN = RWKV_COLS + ATTN_COLS
N_DIR = 2
GRID_W = 64
NA_ROWS = 8
NA_COLS = 16
RMS_EPS = 1e-6
LNX_EPS = 64e-5

kernel_name = 'hybrid_rwkv7_natten2d_encoder'


def rms_norm(x, g):
    xf = x.astype(jnp.float32)
    return xf * lax.rsqrt(jnp.mean(xf * xf, -1, keepdims=True) + RMS_EPS) * g.astype(jnp.float32)


def centred_shift(u, mu):
    prev = jnp.pad(u[:, :-1], ((0, 0), (1, 0), (0, 0)))
    nxt = jnp.pad(u[:, 1:], ((0, 0), (0, 1), (0, 0)))
    return u + mu * (0.5 * (prev + nxt) - u)


def to_scan(u):
    u = jnp.stack([u[0], jnp.flip(u[1], 1)])
    return jnp.moveaxis(u, 2, 0)


def rwkv7_step(S, inp):
    r_t, w_t, k_t, v_t, kk_t, kka_t = inp
    s_kk = jnp.einsum('zbhvk,zbhk->zbhv', S, kk_t)
    S = S * w_t[..., None, :] - s_kk[..., :, None] * kka_t[..., None, :] + v_t[..., :, None] * k_t[..., None, :]
    return S, jnp.einsum('zbhvk,zbhk->zbhv', S, r_t)


def rwkv7_bidir(zr, shift_mu, w0, w_up, a0, a_up, k_k, k_a, r_k, lnx_g, lnx_b):
    f32 = jnp.float32
    B, T, _ = zr.shape
    H, N = N_RWKV_HEADS, RWKV_HEAD
    zr = centred_shift(zr.astype(f32), shift_mu.astype(f32))
    r, k, v, gate = (zr[..., i * D_RWKV:(i + 1) * D_RWKV] for i in range(4))
    w_dn = jnp.tanh(zr[..., 4 * D_RWKV:4 * D_RWKV + DECAY_LORA])
    a_dn = zr[..., 4 * D_RWKV + DECAY_LORA:]
    w_log = -jax.nn.softplus(-(w0.astype(f32)[:, None, None, :]
                               + jnp.einsum('btl,zlc->zbtc', w_dn, w_up.astype(f32)))) - 0.5
    decay = jnp.exp(-jnp.exp(w_log))
    a = jax.nn.sigmoid(a0.astype(f32)[:, None, None, :]
                       + jnp.einsum('btl,zlc->zbtc', a_dn, a_up.astype(f32)))
    heads = lambda u: u.reshape(u.shape[:-1] + (H, N))
    kk = heads(k * k_k.astype(f32))
    kk = kk / jnp.maximum(jnp.sqrt(jnp.sum(kk * kk, -1, keepdims=True)), 1e-12)
    k_dir = heads(k[None] * (1.0 + (a - 1.0) * k_a.astype(f32)))
    r_h, v_h = heads(r), heads(v)
    a_h = heads(a)
    xs = (to_scan(jnp.stack([r_h, r_h])), to_scan(heads(decay)), to_scan(k_dir),
          to_scan(jnp.stack([v_h, v_h])), to_scan(jnp.stack([kk, kk])), to_scan(kk[None] * a_h))
    S0 = jnp.zeros((N_DIR, B, H, N, N), f32)
    _, y = lax.scan(rwkv7_step, S0, xs)
    y = jnp.moveaxis(y, 0, 2)
    y = y[0] + jnp.flip(y[1], 1)
    mu = jnp.mean(y, -1, keepdims=True)
    var = jnp.mean(jnp.square(y - mu), -1, keepdims=True)
    yn = ((y - mu) * lax.rsqrt(var + LNX_EPS)).reshape(B, T, D_RWKV)
    yn = yn * lnx_g.astype(f32) + lnx_b.astype(f32)
    bonus = jnp.sum(r_h[None] * k_dir * r_k.astype(f32), -1, keepdims=True).sum(0) * v_h
    return (yn + bonus.reshape(B, T, D_RWKV)) * jax.nn.silu(gate)


def neighbourhood_attention(q, k, v, rpb):
    f32 = jnp.float32
    B, T, H, Dh = q.shape
    rows = T // GRID_W
    kh = min(NA_ROWS, rows)
    grid = lambda u: u.reshape(B, rows, GRID_W, H, Dh)
    qg, kg, vg = grid(q), grid(k), grid(v)
    row = jnp.arange(rows)
    row_idx = jnp.clip(row - kh // 2, 0, rows - kh)[:, None] + jnp.arange(kh)[None, :]
    k_blk = kg[:, row_idx]
    v_blk = vg[:, row_idx]
    col = jnp.arange(GRID_W)
    col_start = jnp.clip(col - NA_COLS // 2, 0, GRID_W - NA_COLS)
    in_win = (col[None, :] >= col_start[:, None]) & (col[None, :] < col_start[:, None] + NA_COLS)
    dc_idx = jnp.clip(col[None, :] - col[:, None] + NA_COLS - 1, 0, 2 * NA_COLS - 2)
    dr_idx = row_idx - row[:, None] + NA_ROWS - 1
    bias = rpb.astype(f32)[:, :, dc_idx][:, dr_idx]
    bias = bias.transpose(1, 0, 3, 2, 4)
    scale = Dh ** -0.5
    s = jnp.einsum('brqhd,brkwhd->brhqkw', qg, k_blk).astype(f32) * scale + bias
    s = jnp.where(in_win[:, None, :], s, -jnp.inf)
    p = jax.nn.softmax(s.reshape(B, rows, H, GRID_W, kh * GRID_W), axis=-1).reshape(s.shape)
    o = jnp.einsum('brhqkw,brkwhd->brqhd', p.astype(v_blk.dtype), v_blk)
    return o.reshape(B, T, H, Dh)


def attn_branch(za, q_norm_g, k_norm_g, rpb):
    f32 = jnp.float32
    B, T, _ = za.shape
    q, k, v, gate = (za[..., i * D_ATTN:(i + 1) * D_ATTN].astype(f32) for i in range(4))
    heads = lambda u: u.reshape(B, T, N_ATTN_HEADS, ATTN_HEAD)
    q = rms_norm(heads(q), q_norm_g)
    k = rms_norm(heads(k), k_norm_g)
    o = neighbourhood_attention(q, k, heads(v), rpb)
    return o.reshape(B, T, D_ATTN) * jax.nn.silu(gate)


def mixer_layer(x, norm_g, w_in, shift_mu, w0, w_up, a0, a_up, k_k, k_a, r_k,
                lnx_g, lnx_b, q_norm_g, k_norm_g, rpb, w_out):
    h = rms_norm(x, norm_g).astype(x.dtype)
    z = jnp.einsum('btd,de->bte', h, w_in)
    y_r = rwkv7_bidir(z[..., :RWKV_COLS], shift_mu, w0, w_up, a0, a_up, k_k, k_a, r_k, lnx_g, lnx_b)
    y_a = attn_branch(z[..., RWKV_COLS:], q_norm_g, k_norm_g, rpb)
    mixed = jnp.concatenate([y_r, y_a], -1).astype(x.dtype)
    return x + jnp.einsum('bte,ed->btd', mixed, w_out)


def run_trunk(x, norm_g, w_in, shift_mu, w0, w_up, a0, a_up, k_k, k_a, r_k,
              lnx_g, lnx_b, q_norm_g, k_norm_g, rpb, w_out):
    for l in range(DEPTH):
        x = mixer_layer(x, norm_g[l], w_in[l], shift_mu[l], w0[l], w_up[l], a0[l], a_up[l],
                        k_k[l], k_a[l], r_k[l], lnx_g[l], lnx_b[l], q_norm_g[l], k_norm_g[l],
                        rpb[l], w_out[l])
    return x


def setup_inputs(seed: int = 0) -> dict:
    key = jax.random.key(seed)
    ks = jax.random.split(key, 20)
    nrm = jax.random.normal
    return {
        'x_prompt': nrm(ks[0], (BATCH, SEQ, D_MODEL), jnp.float32),
        'x_sample': nrm(ks[1], (DEC_BATCH, DEC_SEQ, D_MODEL), jnp.float32),
        'norm_g': 1.0 + 0.02 * nrm(ks[2], (DEPTH, D_MODEL), jnp.float32),
        'w_in': nrm(ks[3], (DEPTH, D_MODEL, D_IN), jnp.float32) * D_MODEL ** -0.5,
        'shift_mu': jax.random.uniform(ks[4], (DEPTH, RWKV_COLS), jnp.float32),
        'w0': jax.random.uniform(ks[5], (DEPTH, N_DIR, D_RWKV), jnp.float32, minval=-6.0, maxval=0.0),
        'w_up': 0.1 * nrm(ks[6], (DEPTH, N_DIR, DECAY_LORA, D_RWKV), jnp.float32),
        'a0': 0.5 * nrm(ks[7], (DEPTH, N_DIR, D_RWKV), jnp.float32),
        'a_up': 0.1 * nrm(ks[8], (DEPTH, N_DIR, ICLR_LORA, D_RWKV), jnp.float32),
        'k_k': 0.85 + 0.05 * nrm(ks[9], (DEPTH, D_RWKV), jnp.float32),
        'k_a': 1.0 + 0.05 * nrm(ks[10], (DEPTH, D_RWKV), jnp.float32),
        'r_k': 0.1 * nrm(ks[11], (DEPTH, N_RWKV_HEADS, RWKV_HEAD), jnp.float32),
        'lnx_g': 1.0 + 0.02 * nrm(ks[12], (DEPTH, D_RWKV), jnp.float32),
        'lnx_b': 0.02 * nrm(ks[13], (DEPTH, D_RWKV), jnp.float32),
        'q_norm_g': 1.0 + 0.02 * nrm(ks[14], (DEPTH, ATTN_HEAD), jnp.float32),
        'k_norm_g': 1.0 + 0.02 * nrm(ks[15], (DEPTH, ATTN_HEAD), jnp.float32),
        'rpb': 0.1 * nrm(ks[16], (DEPTH, N_ATTN_HEADS, 2 * NA_ROWS - 1, 2 * NA_COLS - 1), jnp.float32),
        'w_out': nrm(ks[17], (DEPTH, D_MIX, D_MODEL), jnp.float32) * D_MIX ** -0.5,
    }


def reference(x_prompt, x_sample, norm_g, w_in, shift_mu, w0, w_up, a0, a_up, k_k, k_a, r_k,
              lnx_g, lnx_b, q_norm_g, k_norm_g, rpb, w_out):
    y_prompt = run_trunk(x_prompt, norm_g, w_in, shift_mu, w0, w_up, a0, a_up, k_k, k_a, r_k,
                         lnx_g, lnx_b, q_norm_g, k_norm_g, rpb, w_out)
    y_sample = run_trunk(x_sample, norm_g, w_in, shift_mu, w0, w_up, a0, a_up, k_k, k_a, r_k,
                         lnx_g, lnx_b, q_norm_g, k_norm_g, rpb, w_out)
    return (y_prompt, y_sample)
```

```cpp
#include <hip/hip_runtime.h>
#include <hip/hip_cooperative_groups.h>
#include <cstdio>
#include <cstdint>
namespace cg = cooperative_groups;

namespace pg8 {
#define PG8_LAS __attribute__((address_space(3)))
typedef unsigned short bf16_t;
typedef short bf16x8 __attribute__((ext_vector_type(8)));
typedef float f32x4 __attribute__((ext_vector_type(4)));
typedef unsigned u32x4 __attribute__((ext_vector_type(4)));
constexpr int BM = 256, BK = 64, HALF = 128, HTB = HALF * BK * 2  , STAGE_BYTES = 8 * HTB, NXCD = 8, WGM = 8;

__host__ __device__ __forceinline__ int lds_byte(int r, int c) { const int st = (r >> 4) * 2 + (c >> 5), rr = r & 15, cc = c & 31, ob = rr * 64 + cc * 2; return st * 1024 + (ob ^ (((ob >> 9) & 1) << 5)); }
__host__ __device__ __forceinline__ void stage_rc(int b, int& R, int& C) { const int st = b / 1024, sb = b % 1024, swz = sb ^ (((sb >> 9) & 1) << 5); R = (st >> 1) * 16 + swz / 64; C = (st & 1) * 32 + (swz % 64) / 2; }
__host__ __device__ __forceinline__ int perm32(int rho) { const int n = rho >> 4, i = rho & 15; return 8 * (i >> 2) + 4 * n + (i & 3); }

struct Unit { int pm, pn; };
struct Gemm { const bf16_t* A; const bf16_t* Bt; int M, N, K; };

struct StaticOrder {
    int nM, nN, nwg, G, c;
    __host__ __device__ void init(int M, int N, int G_, int c_) { nM = M / BM; nN = N / BM; nwg = nM * nN; G = G_; c = c_; }
    __host__ __device__ bool next(int i, Unit& u) const {
        const long L = (long)i * G + c; if (L >= nwg) return false;
        int wgid = (int)L; { const int q = nwg / NXCD, r = nwg % NXCD, xcd = wgid % NXCD, off = wgid / NXCD; wgid = (xcd < r ? xcd * (q + 1) : r * (q + 1) + (xcd - r) * q) + off; }
        const int nig = WGM * nN, gid = wgid / nig, fm = gid * WGM, gsz = (nM - fm) < WGM ? (nM - fm) : WGM;
        u.pm = fm + ((wgid % nig) % gsz); u.pn = (wgid % nig) / gsz; return true;
    }
    __device__ __forceinline__ void a_ready(const Unit&) const {}
    __device__ __forceinline__ void done(const Unit&) const {}
};
__device__ __forceinline__ unsigned cvt_pk_bf16(float lo, float hi) { unsigned r; asm volatile("v_cvt_pk_bf16_f32 %0, %1, %2" : "=v"(r) : "v"(lo), "v"(hi)); return r; }
typedef float f32x2 __attribute__((ext_vector_type(2)));
__device__ __forceinline__ f32x2 gelu_pk(f32x2 v) {
    const f32x2 av = __builtin_elementwise_abs(v), d = av * 0.2316418882f + 1.0f;
    f32x2 t; t.x = __builtin_amdgcn_rcpf(d.x); t.y = __builtin_amdgcn_rcpf(d.y);
    f32x2 q = t * 0.5307027145f + (-0.7265760135f); q = q * t + 0.7107068705f; q = q * t + (-0.142248368f); q = q * t + 0.127414796f; q = q * t;
    const f32x2 s = (v * v) * (-0.72134752044f);
    f32x2 e; e.x = __builtin_amdgcn_exp2f(s.x); e.y = __builtin_amdgcn_exp2f(s.y);
    const f32x2 m = v * (q * e), r = v - m;
    f32x2 o; o.x = v.x < 0.f ? m.x : r.x; o.y = v.y < 0.f ? m.y : r.y; return o;
}
struct EpiF32 {
    static constexpr bool PERM = false, AFTER_DRAIN = false;
    float* C; int ldc; const float* bias;
    __device__ __forceinline__ void operator()(const f32x4 (&acc)[2][2][4][2], const Unit& u, int wr, int wc, int fr, int fq) const {
        const int row0 = u.pm * BM + wr * 64 + fr, col0 = u.pn * BM + wc * 32 + 4 * fq;
        f32x4 bv[2][2];
#pragma unroll
        for (int bj = 0; bj < 2; ++bj)
#pragma unroll
            for (int n = 0; n < 2; ++n) bv[bj][n] = bias ? *(const f32x4*)(bias + col0 + bj * HALF + n * 16) : (f32x4){0.f, 0.f, 0.f, 0.f};
#pragma unroll
        for (int ai = 0; ai < 2; ++ai)
#pragma unroll
            for (int m = 0; m < 4; ++m) { float* rowp = C + (size_t)(row0 + ai * HALF + m * 16) * ldc + col0;
#pragma unroll
                for (int bj = 0; bj < 2; ++bj)
#pragma unroll
                    for (int n = 0; n < 2; ++n) *(f32x4*)(rowp + bj * HALF + n * 16) = acc[ai][bj][m][n] + bv[bj][n]; }
    }
};
template <int ACT  > struct EpiBf16 {
    static constexpr bool PERM = true, AFTER_DRAIN = false;
    bf16_t* O; int ldc; const float* bias; int split_cols; size_t split_stride;
    __device__ __forceinline__ void operator()(const f32x4 (&acc)[2][2][4][2], const Unit& u, int wr, int wc, int fr, int fq) const {
        const int row0 = u.pm * BM + wr * 64 + fr; int colt = u.pn * BM; bf16_t* base = O;
        if (split_cols) { const int t = colt / split_cols; base += (size_t)t * split_stride; colt -= t * split_cols; }
        const int col0 = colt + wc * 32 + 8 * fq, bcol0 = u.pn * BM + wc * 32 + 8 * fq;
        f32x4 bv[2][2];
#pragma unroll
        for (int bj = 0; bj < 2; ++bj)
#pragma unroll
            for (int n = 0; n < 2; ++n) bv[bj][n] = bias ? *(const f32x4*)(bias + bcol0 + bj * HALF + 4 * n) : (f32x4){0.f, 0.f, 0.f, 0.f};
#pragma unroll
        for (int ai = 0; ai < 2; ++ai)
#pragma unroll
            for (int m = 0; m < 4; ++m) { bf16_t* rowp = base + (size_t)(row0 + ai * HALF + m * 16) * ldc + col0;
#pragma unroll
                for (int bj = 0; bj < 2; ++bj) { f32x4 v0 = acc[ai][bj][m][0] + bv[bj][0], v1 = acc[ai][bj][m][1] + bv[bj][1];
                    if (ACT == 1) { f32x2 a = gelu_pk((f32x2){v0[0], v0[1]}), b = gelu_pk((f32x2){v0[2], v0[3]}), c = gelu_pk((f32x2){v1[0], v1[1]}), d = gelu_pk((f32x2){v1[2], v1[3]});
                        v0 = (f32x4){a.x, a.y, b.x, b.y}; v1 = (f32x4){c.x, c.y, d.x, d.y}; }
                    if (ACT == 2) {
#pragma unroll
                        for (int j = 0; j < 4; ++j) { v0[j] = 0.5f * v0[j] * (1.0f + erff(v0[j] * 0.70710678f)); v1[j] = 0.5f * v1[j] * (1.0f + erff(v1[j] * 0.70710678f)); } }
                    u32x4 w; w.x = cvt_pk_bf16(v0[0], v0[1]); w.y = cvt_pk_bf16(v0[2], v0[3]); w.z = cvt_pk_bf16(v1[0], v1[1]); w.w = cvt_pk_bf16(v1[2], v1[3]);
                    *(u32x4*)(rowp + bj * HALF) = w; } }
    }
};
struct EpiResF32 {
    static constexpr bool PERM = false, AFTER_DRAIN = false;
    const float* xp; const float* xs; float* C;
    __device__ __forceinline__ void operator()(const f32x4 (&acc)[2][2][4][2], const Unit& u, int wr, int wc, int fr, int fq) const {
        const int row0 = u.pm * BM + wr * 64 + fr, col0 = u.pn * BM + wc * 32 + 4 * fq;
#pragma unroll
        for (int ai = 0; ai < 2; ++ai)
#pragma unroll
            for (int m = 0; m < 4; ++m) {
                const int row = row0 + ai * HALF + m * 16;
                const float* xr = (row < 32768 ? xp + (size_t)row * 1024 : xs + (size_t)(row - 32768) * 1024) + col0;
                float* rowp = C + (size_t)row * 1024 + col0;
#pragma unroll
                for (int bj = 0; bj < 2; ++bj)
#pragma unroll
                    for (int n = 0; n < 2; ++n) *(f32x4*)(rowp + bj * HALF + n * 16) = acc[ai][bj][m][n] + *(const f32x4*)(xr + bj * HALF + n * 16);
            }
    }
};
template <class Epi, class Sched, bool STAMP = false>
__device__ __forceinline__ void gemm_phase(PG8_LAS unsigned char* lds, const Gemm g, const Sched& S, const Epi& E, unsigned long long* stamps) {
    const int tid = threadIdx.x, wid = __builtin_amdgcn_readfirstlane(tid >> 6), lane = tid & 63, wr = wid >> 2, wc = wid & 3, fr = lane & 15, fq = lane >> 4;
    const int K = g.K, nt = K / BK;
    int ts_lo = 0, ts_hi = 0, nts = 0; const unsigned long long rt_entry = STAMP ? (unsigned long long)wall_clock64() : 0ull;
#define PG8_STAMP() do { if (STAMP && wid == 0 && nts < 64) { const unsigned long long _c = (unsigned long long)clock64(); \
        ts_lo = (lane == nts) ? (int)(unsigned)_c : ts_lo; ts_hi = (lane == nts) ? (int)(unsigned)(_c >> 32) : ts_hi; ++nts; } } while (0)
    PG8_STAMP();
    unsigned voffA[2], voffB[2];
#pragma unroll
    for (int i = 0; i < 2; ++i) { int R, C; stage_rc(tid * 16 + i * 8192, R, C); const int Rb = Epi::PERM ? ((R & ~31) + perm32(R & 31)) : R;
        voffA[i] = (unsigned)(R * K + C) * 2u; voffB[i] = (unsigned)(Rb * K + C) * 2u; }
    const size_t kstep = (size_t)(BK * 2);
    const size_t hstep = (size_t)HALF * K * 2;
    const size_t tstep = 2 * hstep;
    const unsigned ldsw = (unsigned)wid * 1024u;
    const int aoff = lds_byte(wr * 64 + fr, fq * 8), boff = lds_byte(wc * 32 + fr, fq * 8);
#define PG8_SA(b, h) (((b) * 2 + (h)) * HTB)
#define PG8_SB(b, h) ((4 + (b) * 2 + (h)) * HTB)
#define PG8_STAGE(bufoff, gbase, voff) do { _Pragma("unroll") for (int _i = 0; _i < 2; ++_i) \
        __builtin_amdgcn_global_load_lds((const unsigned*)((const char*)(gbase) + (voff)[_i]), (PG8_LAS unsigned*)(lds + (bufoff) + ldsw + _i * 8192), 16, 0, 0); } while (0)
#define PG8_LDA(dst, b, h) do { _Pragma("unroll") for (int m = 0; m < 4; ++m) _Pragma("unroll") for (int k = 0; k < 2; ++k) dst[m][k] = *(const PG8_LAS bf16x8*)(lds + PG8_SA(b, h) + aoff + m * 2048 + k * 1024); } while (0)
#define PG8_LDB(dst, b, h) do { _Pragma("unroll") for (int n = 0; n < 2; ++n) _Pragma("unroll") for (int k = 0; k < 2; ++k) dst[n][k] = *(const PG8_LAS bf16x8*)(lds + PG8_SB(b, h) + boff + n * 2048 + k * 1024); } while (0)
#define PG8_MMA(ai, bj, At, Bt) do { __builtin_amdgcn_s_setprio(1); _Pragma("unroll") for (int m = 0; m < 4; ++m) _Pragma("unroll") for (int n = 0; n < 2; ++n) _Pragma("unroll") for (int k = 0; k < 2; ++k) \
        acc[ai][bj][m][n] = __builtin_amdgcn_mfma_f32_16x16x32_bf16(Bt[n][k], At[m][k], acc[ai][bj][m][n], 0, 0, 0); __builtin_amdgcn_s_setprio(0); } while (0)
#define PG8_WAIT_V(n) asm volatile("s_waitcnt vmcnt(" #n ")" ::: "memory")
#define PG8_WAIT_L(n) asm volatile("s_waitcnt lgkmcnt(" #n ")" ::: "memory")
#define PG8_BAR __builtin_amdgcn_s_barrier()
#define PG8_SCHED __builtin_amdgcn_sched_barrier(0)
    Unit cur, nxt; int ui = 0;
    if (!S.next(0, cur)) return;
    f32x4 acc[2][2][4][2];
#pragma unroll
    for (int a = 0; a < 2; ++a)
#pragma unroll
        for (int b = 0; b < 2; ++b)
#pragma unroll
            for (int m = 0; m < 4; ++m)
#pragma unroll
                for (int n = 0; n < 2; ++n) acc[a][b][m][n] = (f32x4){0.f, 0.f, 0.f, 0.f};
    bf16x8 At[4][2], B0[2][2], B1[2][2];
    const char* cA = (const char*)g.A + (size_t)cur.pm * tstep; const char* cB = (const char*)g.Bt + (size_t)cur.pn * tstep;
    S.a_ready(cur);
    PG8_STAGE(PG8_SB(0, 0), cB, voffB); PG8_STAGE(PG8_SA(0, 0), cA, voffA); PG8_STAGE(PG8_SB(0, 1), cB + hstep, voffB); PG8_STAGE(PG8_SA(0, 1), cA + hstep, voffA);
    if (wr == 1) PG8_BAR;
    PG8_WAIT_V(4); PG8_BAR;
    PG8_STAGE(PG8_SB(1, 0), cB + kstep, voffB); PG8_STAGE(PG8_SA(1, 0), cA + kstep, voffA); PG8_STAGE(PG8_SB(1, 1), cB + hstep + kstep, voffB);
    PG8_WAIT_V(6); PG8_BAR;
    PG8_STAMP();
    for (;;) {
        const bool has_next = S.next(ui + 1, nxt);
        const char* nA = has_next ? (const char*)g.A + (size_t)nxt.pm * tstep : cA; const char* nB = has_next ? (const char*)g.Bt + (size_t)nxt.pn * tstep : cB;
        for (int t = 0; t < nt; t += 2) {
            const bool last = (t == nt - 2);
            const char* a1 = cA + (size_t)(t + 1) * kstep;
            const char* a2 = last ? nA : cA + (size_t)(t + 2) * kstep; const char* b2 = last ? nB : cB + (size_t)(t + 2) * kstep;
            const char* a3 = a2 + kstep; const char* b3 = b2 + kstep;
            if (last && has_next) S.a_ready(nxt);
            PG8_LDB(B0, 0, 0); PG8_SCHED; PG8_LDA(At, 0, 0); PG8_STAGE(PG8_SA(1, 1), a1 + hstep, voffA);
            PG8_WAIT_L(8); PG8_BAR; PG8_WAIT_L(0); PG8_MMA(0, 0, At, B0); PG8_BAR; PG8_SCHED;
            PG8_LDB(B1, 0, 1); PG8_STAGE(PG8_SB(0, 0), b2, voffB);
            PG8_BAR; PG8_WAIT_L(0); PG8_MMA(0, 1, At, B1); PG8_BAR;
            PG8_LDA(At, 0, 1); PG8_STAGE(PG8_SA(0, 0), a2, voffA);
            PG8_BAR; PG8_WAIT_L(0); PG8_MMA(1, 0, At, B0); PG8_BAR; PG8_SCHED;
            PG8_STAGE(PG8_SB(0, 1), b2 + hstep, voffB);
            PG8_WAIT_V(6); PG8_BAR; PG8_MMA(1, 1, At, B1); PG8_BAR;
            PG8_LDB(B0, 1, 0); PG8_SCHED; PG8_LDA(At, 1, 0); PG8_STAGE(PG8_SA(0, 1), a2 + hstep, voffA);
            PG8_WAIT_L(8); PG8_BAR; PG8_WAIT_L(0); PG8_MMA(0, 0, At, B0); PG8_BAR; PG8_SCHED;
            PG8_LDB(B1, 1, 1); PG8_STAGE(PG8_SB(1, 0), b3, voffB);
            PG8_BAR; PG8_WAIT_L(0); PG8_MMA(0, 1, At, B1); PG8_BAR;
            PG8_LDA(At, 1, 1); PG8_STAGE(PG8_SA(1, 0), a3, voffA);
            PG8_BAR; PG8_WAIT_L(0); PG8_MMA(1, 0, At, B0); PG8_BAR; PG8_SCHED;
            PG8_STAGE(PG8_SB(1, 1), b3 + hstep, voffB);
            PG8_WAIT_V(6); PG8_BAR; PG8_MMA(1, 1, At, B1); PG8_BAR;
        }
        PG8_STAMP();
        if constexpr (!Epi::AFTER_DRAIN) { E(acc, cur, wr, wc, fr, fq); S.done(cur); }
        PG8_STAMP();
        if (!has_next) break;
#pragma unroll
        for (int a = 0; a < 2; ++a)
#pragma unroll
            for (int b = 0; b < 2; ++b)
#pragma unroll
                for (int m = 0; m < 4; ++m)
#pragma unroll
                    for (int n = 0; n < 2; ++n) acc[a][b][m][n] = (f32x4){0.f, 0.f, 0.f, 0.f};
        cur = nxt; cA = nA; cB = nB; ++ui;
    }
    PG8_WAIT_V(0);
    if (wr == 0) PG8_BAR;
    PG8_BAR;
    if constexpr (Epi::AFTER_DRAIN) { E.fused(acc, cur, wr, wc, fr, fq, lds, wid, lane); S.done(cur); }
    PG8_STAMP();
    if (STAMP && wid == 0) { stamps[lane] = lane < nts ? (((unsigned long long)(unsigned)ts_hi << 32) | (unsigned)ts_lo) : 0ull;
        if (lane == 62) stamps[62] = rt_entry; if (lane == 63) stamps[63] = (unsigned long long)wall_clock64(); }
#undef PG8_STAMP
#undef PG8_SA
#undef PG8_SB
#undef PG8_STAGE
#undef PG8_LDA
#undef PG8_LDB
#undef PG8_MMA
#undef PG8_WAIT_V
#undef PG8_WAIT_L
#undef PG8_BAR
#undef PG8_SCHED
}
}
#define GAS __attribute__((address_space(1)))
#define LAS __attribute__((address_space(3)))
typedef unsigned short bf16;
typedef float f32x4 __attribute__((ext_vector_type(4)));
typedef unsigned u32x4 __attribute__((ext_vector_type(4)));
typedef unsigned u32x2 __attribute__((ext_vector_type(2)));
constexpr int DM = 1024, M_TOK = 98304, M_PROMPT = 32768, T_PROMPT = 16384, T_SAMPLE = 4096, NSEQ = 18;
constexpr int DIN = 4224, DINP = 4352, DRW = 512, NH = 8, HD = 64;
constexpr int C_R = 0, C_K = 512, C_V = 1024, C_G = 1536, C_WDN = 2048, C_ADN = 2112, C_AQ = 2176, C_AK = 2688, C_AV = 3200, C_AG = 3712;
constexpr int NWAVES = 8, NTHREADS = 512;
constexpr int LDS_BYTES = 147456;
constexpr size_t MiB = 1u << 20;
constexpr size_t WS_CTL = 0;
constexpr size_t WS_WINT = 2 * MiB;
constexpr size_t WS_WOUTT = 12 * MiB;
constexpr size_t WS_Z = 16 * MiB;
constexpr size_t WS_MIXED = WS_Z + (size_t)M_TOK * DINP * 2;
constexpr size_t WS_END = WS_MIXED + (size_t)M_TOK * DM * 2;

struct Params {
    const float* x_prompt; const float* x_sample; const float* norm_g; const float* w_in; const float* shift_mu; const float* w0; const float* w_up;
    const float* a0; const float* a_up; const float* k_k; const float* k_a; const float* r_k; const float* lnx_g; const float* lnx_b;
    const float* q_norm_g; const float* k_norm_g; const float* rpb; const float* w_out;
    float* out; unsigned char* ws;
};

__device__ __forceinline__ unsigned f2bf(float f) { unsigned u = __builtin_bit_cast(unsigned, f); return (u + 0x7fffu + ((u >> 16) & 1u)) >> 16; }
__device__ __forceinline__ unsigned pk2(float lo, float hi) { return f2bf(lo) | (f2bf(hi) << 16); }
__device__ __forceinline__ float bf2f(unsigned b) { return __builtin_bit_cast(float, b << 16); }
__device__ __forceinline__ float bflo(unsigned w) { return __builtin_bit_cast(float, w << 16); }
__device__ __forceinline__ float bfhi(unsigned w) { return __builtin_bit_cast(float, w & 0xffff0000u); }
__device__ __forceinline__ float wave_sum(float v) {
#pragma unroll
    for (int o = 1; o < 64; o <<= 1) v += __shfl_xor(v, o);
    return v;
}
__device__ __forceinline__ float sigmoidf_(float x) { return 1.0f / (1.0f + __expf(-x)); }
__device__ __forceinline__ void seq_of_token(int m, int& t, int& T) { if (m < M_PROMPT) { t = m & (T_PROMPT - 1); T = T_PROMPT; } else { t = (m - M_PROMPT) & (T_SAMPLE - 1); T = T_SAMPLE; } }
__device__ __forceinline__ void seq_info(int s, int& start, int& len) { if (s < 2) { start = s * T_PROMPT; len = T_PROMPT; } else { start = M_PROMPT + (s - 2) * T_SAMPLE; len = T_SAMPLE; } }

__device__ __forceinline__ void p0_transpose_item(const float* W, int K, int N, bf16* WT, LAS float* scr, int item, int lane) {
    const int nblk = N / 32, kb = item / nblk, nb = item % nblk, k0 = 64 * kb, n0 = 32 * nb;
#pragma unroll 8
    for (int i = 0; i < 32; ++i) { const int kk = 2 * i + (lane >> 5); scr[kk * 33 + (lane & 31)] = W[(size_t)(k0 + kk) * N + n0 + (lane & 31)]; }
    asm volatile("s_waitcnt lgkmcnt(0)" ::: "memory");
    const int c = lane & 7;
#pragma unroll
    for (int j = 0; j < 4; ++j) { const int n = (lane >> 3) + 8 * j; const LAS float* s = scr + (8 * c) * 33 + n;
        u32x4 o; o.x = pk2(s[0 * 33], s[1 * 33]); o.y = pk2(s[2 * 33], s[3 * 33]); o.z = pk2(s[4 * 33], s[5 * 33]); o.w = pk2(s[6 * 33], s[7 * 33]);
        *(u32x4*)(WT + (size_t)(n0 + n) * K + k0 + 8 * c) = o; }
    asm volatile("s_waitcnt lgkmcnt(0)" ::: "memory");
}
__device__ __forceinline__ void p0_prologue(const Params& p, LAS unsigned char* lds, int wave, int lane) {
    LAS float* scr = (LAS float*)(lds + wave * 16384);
    const int gw = blockIdx.x * NWAVES + wave, NGW = gridDim.x * NWAVES;
    bf16* WinT = (bf16*)(p.ws + WS_WINT); bf16* WoutT = (bf16*)(p.ws + WS_WOUTT);
    constexpr int I_IN = (DM / 64) * (DIN / 32), I_OUT = (DM / 64) * (DM / 32);
    for (int it = gw; it < I_IN + I_OUT; it += NGW) {
        if (it < I_IN) p0_transpose_item(p.w_in, DM, DIN, WinT, scr, it, lane);
        else p0_transpose_item(p.w_out, DM, DM, WoutT, scr, it - I_IN, lane);
    }
    { const size_t n16 = (size_t)(DINP - DIN) * DM * 2 / 16; u32x4* z = (u32x4*)(WinT + (size_t)DIN * DM);
      for (size_t i = (size_t)gw * 64 + lane; i < n16; i += (size_t)NGW * 64) z[i] = (u32x4){0u, 0u, 0u, 0u}; }
    bf16* Hb = (bf16*)p.out;
    const f32x4* gr = (const f32x4*)p.norm_g + lane;
    f32x4 gv[4];
#pragma unroll
    for (int j = 0; j < 4; ++j) gv[j] = gr[64 * j];
    for (int m = gw; m < M_TOK; m += NGW) {
        const float* xrow = (m < M_PROMPT) ? p.x_prompt + (size_t)m * DM : p.x_sample + (size_t)(m - M_PROMPT) * DM;
        const f32x4* xr = (const f32x4*)xrow + lane;
        f32x4 v[4]; float s = 0.f;
#pragma unroll
        for (int j = 0; j < 4; ++j) { v[j] = xr[64 * j]; s += (v[j].x * v[j].x + v[j].y * v[j].y) + (v[j].z * v[j].z + v[j].w * v[j].w); }
        const float rstd = 1.0f / sqrtf(wave_sum(s) * (1.0f / DM) + 1e-6f);
        unsigned long long* o8 = (unsigned long long*)(Hb + (size_t)m * DM) + lane;
#pragma unroll
        for (int j = 0; j < 4; ++j) { const f32x4 w = v[j] * rstd * gv[j]; o8[64 * j] = (unsigned long long)pk2(w.x, w.y) | ((unsigned long long)pk2(w.z, w.w) << 32); }
    }
}

__device__ __forceinline__ void qk_norm_phase(const Params& p, int wave, int lane) {
    const int gw = blockIdx.x * NWAVES + wave, NGW = gridDim.x * NWAVES;
    bf16* Z = (bf16*)(p.ws + WS_Z);
    const int sub = lane & 7, head = lane >> 3;
    float gq[8], gk[8];
#pragma unroll
    for (int i = 0; i < 8; ++i) { gq[i] = p.q_norm_g[sub * 8 + i] * 0.125f; gk[i] = p.k_norm_g[sub * 8 + i]; }
    for (int m = gw; m < M_TOK; m += NGW) {
#pragma unroll
        for (int which = 0; which < 2; ++which) {
            u32x4* ptr = (u32x4*)(Z + (size_t)m * DINP + (which ? C_AK : C_AQ) + head * 64 + sub * 8);
            const u32x4 w = *ptr;
            float f[8] = {bflo(w.x), bfhi(w.x), bflo(w.y), bfhi(w.y), bflo(w.z), bfhi(w.z), bflo(w.w), bfhi(w.w)};
            float ss = 0.f;
#pragma unroll
            for (int i = 0; i < 8; ++i) ss += f[i] * f[i];
            ss += __shfl_xor(ss, 1); ss += __shfl_xor(ss, 2); ss += __shfl_xor(ss, 4);
            const float rstd = 1.0f / sqrtf(ss * (1.0f / 64.0f) + 1e-6f);
#pragma unroll
            for (int i = 0; i < 8; ++i) f[i] = f[i] * rstd * (which ? gk[i] : gq[i]);
            u32x4 o; o.x = pk2(f[0], f[1]); o.y = pk2(f[2], f[3]); o.z = pk2(f[4], f[5]); o.w = pk2(f[6], f[7]);
            *ptr = o;
        }
    }
}

__device__ __forceinline__ void na_phase_simple(const Params& p, int wave, int lane) {
    const int gw = blockIdx.x * NWAVES + wave, NGW = gridDim.x * NWAVES;
    const bf16* Z = (const bf16*)(p.ws + WS_Z);
    bf16* MX = (bf16*)(p.ws + WS_MIXED);
    constexpr int NROWS = 2 * (T_PROMPT / 64) + 16 * (T_SAMPLE / 64);
    for (int item = gw; item < NROWS * NH; item += NGW) {
        const int head = item & 7, rowg = item >> 3;
        int seq, r, rows;
        if (rowg < 512) { seq = rowg >> 8; r = rowg & 255; rows = 256; } else { const int rr = rowg - 512; seq = 2 + (rr >> 6); r = rr & 63; rows = 64; }
        int start, len; seq_info(seq, start, len);
        const int mq = start + r * 64 + lane;
        u32x4 qv[8];
        { const u32x4* qp = (const u32x4*)(Z + (size_t)mq * DINP + C_AQ + head * 64);
#pragma unroll
          for (int i = 0; i < 8; ++i) qv[i] = qp[i]; }
        int kr0 = r - 4; kr0 = kr0 < 0 ? 0 : (kr0 > rows - 8 ? rows - 8 : kr0);
        int cs = lane - 8; cs = cs < 0 ? 0 : (cs > 48 ? 48 : cs);
        float o[64];
#pragma unroll
        for (int d = 0; d < 64; ++d) o[d] = 0.f;
        float mrun = -1e30f, lsum = 0.f;
        for (int kr = 0; kr < 8; ++kr) {
            const float* bias_row = p.rpb + ((size_t)head * 15 + (kr0 + kr - r + 7)) * 31 + (cs - lane + 15);
            const bf16* krow = Z + (size_t)(start + (kr0 + kr) * 64 + cs) * DINP + head * 64;
#pragma unroll 1
            for (int j = 0; j < 16; ++j) {
                const u32x4* kp = (const u32x4*)(krow + (size_t)j * DINP + C_AK);
                float s = 0.f;
#pragma unroll
                for (int i = 0; i < 8; ++i) { const u32x4 kv = kp[i];
                    s += bflo(qv[i].x) * bflo(kv.x) + bfhi(qv[i].x) * bfhi(kv.x) + bflo(qv[i].y) * bflo(kv.y) + bfhi(qv[i].y) * bfhi(kv.y)
                       + bflo(qv[i].z) * bflo(kv.z) + bfhi(qv[i].z) * bfhi(kv.z) + bflo(qv[i].w) * bflo(kv.w) + bfhi(qv[i].w) * bfhi(kv.w); }
                s += bias_row[j];
                const float mnew = fmaxf(mrun, s);
                const float alpha = __expf(mrun - mnew);
                const float pj = __expf(s - mnew);
                mrun = mnew;
                lsum = lsum * alpha + pj;
                const u32x4* vp = (const u32x4*)(krow + (size_t)j * DINP + C_AV);
#pragma unroll
                for (int i = 0; i < 8; ++i) { const u32x4 vv = vp[i];
                    o[8 * i + 0] = o[8 * i + 0] * alpha + pj * bflo(vv.x); o[8 * i + 1] = o[8 * i + 1] * alpha + pj * bfhi(vv.x);
                    o[8 * i + 2] = o[8 * i + 2] * alpha + pj * bflo(vv.y); o[8 * i + 3] = o[8 * i + 3] * alpha + pj * bfhi(vv.y);
                    o[8 * i + 4] = o[8 * i + 4] * alpha + pj * bflo(vv.z); o[8 * i + 5] = o[8 * i + 5] * alpha + pj * bfhi(vv.z);
                    o[8 * i + 6] = o[8 * i + 6] * alpha + pj * bflo(vv.w); o[8 * i + 7] = o[8 * i + 7] * alpha + pj * bfhi(vv.w); }
            }
        }
        const float inv = 1.0f / lsum;
        const u32x4* gp = (const u32x4*)(Z + (size_t)mq * DINP + C_AG + head * 64);
        u32x4* op = (u32x4*)(MX + (size_t)mq * DM + DRW + head * 64);
#pragma unroll
        for (int i = 0; i < 8; ++i) { const u32x4 gv = gp[i];
            const float g[8] = {bflo(gv.x), bfhi(gv.x), bflo(gv.y), bfhi(gv.y), bflo(gv.z), bfhi(gv.z), bflo(gv.w), bfhi(gv.w)};
            float r8[8];
#pragma unroll
            for (int e = 0; e < 8; ++e) r8[e] = o[8 * i + e] * inv * g[e] * sigmoidf_(g[e]);
            u32x4 w; w.x = pk2(r8[0], r8[1]); w.y = pk2(r8[2], r8[3]); w.z = pk2(r8[4], r8[5]); w.w = pk2(r8[6], r8[7]);
            op[i] = w; }
    }
}

constexpr int SB = 32;
constexpr int ZS_OFF = 0, ZS_BYTES = SB * 320 * 4;
constexpr int BUF_OFF = ZS_BYTES, BUF_BYTES = 6 * SB * 64 * 4;
static_assert(BUF_OFF + 2 * BUF_BYTES <= LDS_BYTES, "scan LDS");
__device__ __forceinline__ void scan_chain_simple(const Params& p, LAS unsigned char* lds, int z, int seq, int h, int wave, int lane) {
    const bf16* Z = (const bf16*)(p.ws + WS_Z);
    float* Y = p.out + (size_t)z * M_TOK * DRW;
    int start, T; seq_info(seq, start, T);
    const int nblk = T / SB;
    LAS float* zs = (LAS float*)(lds + ZS_OFF);
    float S[64];
#pragma unroll
    for (int k = 0; k < 64; ++k) S[k] = 0.f;
    const int hc = h * 64 + lane;
    const float w0c = p.w0[z * DRW + hc], a0c = p.a0[z * DRW + hc], kkc = p.k_k[hc], kac = p.k_a[hc];
    const float* wup = p.w_up + (size_t)z * 64 * DRW + hc;
    const float* aup = p.a_up + (size_t)z * 64 * DRW + hc;
    for (int nb = -1; nb < nblk; ++nb) {
        if (nb + 1 < nblk) {
            for (int e = threadIdx.x; e < SB * 320; e += NTHREADS) {
                const int tok = e / 320, col = e - tok * 320, seg = col >> 6, j = col & 63;
                const int zcol = seg < 3 ? (seg * 512 + h * 64 + j) : (C_WDN + (seg - 3) * 64 + j);
                const int pos = (nb + 1) * SB + tok, t = z ? (T - 1 - pos) : pos;
                const bf16* zp = Z + (size_t)(start + t) * DINP + zcol;
                const float u0 = bf2f(zp[0]);
                const float um = t > 0 ? bf2f(zp[-DINP]) : 0.f;
                const float up = t < T - 1 ? bf2f(zp[DINP]) : 0.f;
                float val = u0 + p.shift_mu[zcol] * (0.5f * (um + up) - u0);
                if (seg == 3) val = tanhf(val);
                zs[e] = val;
            }
        }
        __syncthreads();
        if (wave > 0) {
            if (nb + 1 < nblk) {
                LAS float* ob = (LAS float*)(lds + BUF_OFF + ((nb + 1) & 1) * BUF_BYTES);
                for (int tok = wave - 1; tok < SB; tok += 7) {
                    const LAS float* zr = zs + tok * 320;
                    float wl = 0.f, al = 0.f;
#pragma unroll 8
                    for (int l = 0; l < 64; ++l) { wl += zr[192 + l] * wup[(size_t)l * DRW]; al += zr[256 + l] * aup[(size_t)l * DRW]; }
                    const float xw = w0c + wl;
                    const float sp = fmaxf(-xw, 0.f) + log1pf(__expf(-fabsf(xw)));
                    const float decay = __expf(-__expf(-sp - 0.5f));
                    const float a = sigmoidf_(a0c + al);
                    const float r = zr[lane], k = zr[64 + lane], v = zr[128 + lane];
                    const float kkr = k * kkc;
                    const float nrm = sqrtf(wave_sum(kkr * kkr));
                    const float kk = kkr / fmaxf(nrm, 1e-12f);
                    ob[0 * SB * 64 + tok * 64 + lane] = r;
                    ob[1 * SB * 64 + tok * 64 + lane] = decay;
                    ob[2 * SB * 64 + tok * 64 + lane] = k * (1.0f + (a - 1.0f) * kac);
                    ob[3 * SB * 64 + tok * 64 + lane] = v;
                    ob[4 * SB * 64 + tok * 64 + lane] = kk;
                    ob[5 * SB * 64 + tok * 64 + lane] = kk * a;
                }
            }
        } else if (nb >= 0) {
            const LAS float* ib = (const LAS float*)(lds + BUF_OFF + (nb & 1) * BUF_BYTES);
            for (int tok = 0; tok < SB; ++tok) {
                const LAS f32x4* r4 = (const LAS f32x4*)(ib + 0 * SB * 64 + tok * 64);
                const LAS f32x4* w4 = (const LAS f32x4*)(ib + 1 * SB * 64 + tok * 64);
                const LAS f32x4* k4 = (const LAS f32x4*)(ib + 2 * SB * 64 + tok * 64);
                const LAS f32x4* kk4 = (const LAS f32x4*)(ib + 4 * SB * 64 + tok * 64);
                const LAS f32x4* ka4 = (const LAS f32x4*)(ib + 5 * SB * 64 + tok * 64);
                const float vi = ib[3 * SB * 64 + tok * 64 + lane];
                float skk0 = 0.f, skk1 = 0.f, skk2 = 0.f, skk3 = 0.f;
#pragma unroll
                for (int q = 0; q < 16; ++q) { const f32x4 c = kk4[q]; skk0 += S[4 * q] * c.x; skk1 += S[4 * q + 1] * c.y; skk2 += S[4 * q + 2] * c.z; skk3 += S[4 * q + 3] * c.w; }
                const float nskk = -((skk0 + skk1) + (skk2 + skk3));
                float y0 = 0.f, y1 = 0.f, y2 = 0.f, y3 = 0.f;
#pragma unroll
                for (int q = 0; q < 16; ++q) { const f32x4 wv = w4[q], kv = k4[q], av = ka4[q], rv = r4[q];
                    S[4 * q + 0] = S[4 * q + 0] * wv.x + (vi * kv.x + nskk * av.x); y0 += S[4 * q + 0] * rv.x;
                    S[4 * q + 1] = S[4 * q + 1] * wv.y + (vi * kv.y + nskk * av.y); y1 += S[4 * q + 1] * rv.y;
                    S[4 * q + 2] = S[4 * q + 2] * wv.z + (vi * kv.z + nskk * av.z); y2 += S[4 * q + 2] * rv.z;
                    S[4 * q + 3] = S[4 * q + 3] * wv.w + (vi * kv.w + nskk * av.w); y3 += S[4 * q + 3] * rv.w; }
                const int pos = nb * SB + tok, t = z ? (T - 1 - pos) : pos;
                Y[(size_t)(start + t) * DRW + hc] = (y0 + y1) + (y2 + y3);
            }
        }
        __syncthreads();
    }
}
__device__ __forceinline__ void scan_phase_simple(const Params& p, LAS unsigned char* lds, int wave, int lane) {
    const int b = blockIdx.x;
    if (b < 32) { scan_chain_simple(p, lds, b & 1, b >> 4, (b >> 1) & 7, wave, lane); }
    else {
        for (int q = b - 32; q < 256; q += (int)gridDim.x - 32) scan_chain_simple(p, lds, q & 1, 2 + (q >> 4), (q >> 1) & 7, wave, lane);
    }
}

__device__ __forceinline__ void mix_phase(const Params& p, LAS unsigned char* lds, int wave, int lane) {
    const bf16* Z = (const bf16*)(p.ws + WS_Z);
    bf16* MX = (bf16*)(p.ws + WS_MIXED);
    const float* Yf = p.out; const float* Yb = p.out + (size_t)M_TOK * DRW;
    LAS float* adn = (LAS float*)lds;
    const int c = threadIdx.x;
    float au0[64], au1[64];
#pragma unroll
    for (int l = 0; l < 64; ++l) { au0[l] = p.a_up[(size_t)l * DRW + c]; au1[l] = p.a_up[(size_t)(64 + l) * DRW + c]; }
    const float mu_r = p.shift_mu[C_R + c], mu_k = p.shift_mu[C_K + c], mu_v = p.shift_mu[C_V + c], mu_g = p.shift_mu[C_G + c];
    const float a00 = p.a0[c], a01 = p.a0[DRW + c], kac = p.k_a[c], rkc = p.r_k[c], lg = p.lnx_g[c], lb = p.lnx_b[c];
    const int tk_s = threadIdx.x >> 6, l_s = threadIdx.x & 63;
    const float mu_a = p.shift_mu[C_ADN + l_s];
    for (int g = blockIdx.x; g < M_TOK / 8; g += gridDim.x) {
        { const int m = g * 8 + tk_s; int t, T; seq_of_token(m, t, T);
          const bf16* zp = Z + (size_t)m * DINP + C_ADN + l_s;
          const float u0 = bf2f(zp[0]), um = t > 0 ? bf2f(zp[-DINP]) : 0.f, up = t < T - 1 ? bf2f(zp[DINP]) : 0.f;
          adn[tk_s * 64 + l_s] = u0 + mu_a * (0.5f * (um + up) - u0); }
        __syncthreads();
        for (int tk = 0; tk < 8; ++tk) {
            const int m = g * 8 + tk; int t, T; seq_of_token(m, t, T);
            const bf16* zp = Z + (size_t)m * DINP + c;
            const bool hp = t > 0, hn = t < T - 1;
            float r0 = bf2f(zp[C_R]), k0 = bf2f(zp[C_K]), v0 = bf2f(zp[C_V]), g0 = bf2f(zp[C_G]);
            float rm = hp ? bf2f(zp[C_R - DINP]) : 0.f, km = hp ? bf2f(zp[C_K - DINP]) : 0.f, vm = hp ? bf2f(zp[C_V - DINP]) : 0.f, gm = hp ? bf2f(zp[C_G - DINP]) : 0.f;
            float rp = hn ? bf2f(zp[C_R + DINP]) : 0.f, kp = hn ? bf2f(zp[C_K + DINP]) : 0.f, vp = hn ? bf2f(zp[C_V + DINP]) : 0.f, gp = hn ? bf2f(zp[C_G + DINP]) : 0.f;
            const float r = r0 + mu_r * (0.5f * (rm + rp) - r0), k = k0 + mu_k * (0.5f * (km + kp) - k0);
            const float v = v0 + mu_v * (0.5f * (vm + vp) - v0), gt = g0 + mu_g * (0.5f * (gm + gp) - g0);
            float al0 = a00, al1 = a01;
            const LAS f32x4* ad4 = (const LAS f32x4*)(adn + tk * 64);
#pragma unroll
            for (int q = 0; q < 16; ++q) { const f32x4 a4 = ad4[q];
                al0 += a4.x * au0[4 * q] + a4.y * au0[4 * q + 1] + a4.z * au0[4 * q + 2] + a4.w * au0[4 * q + 3];
                al1 += a4.x * au1[4 * q] + a4.y * au1[4 * q + 1] + a4.z * au1[4 * q + 2] + a4.w * au1[4 * q + 3]; }
            const float as = sigmoidf_(al0) + sigmoidf_(al1);
            const float ksum = k * (2.0f + (as - 2.0f) * kac);
            const float bonus = wave_sum(r * rkc * ksum);
            const float y = Yf[(size_t)m * DRW + c] + Yb[(size_t)m * DRW + c];
            const float mean = wave_sum(y) * (1.0f / 64.0f);
            const float d = y - mean;
            const float var = wave_sum(d * d) * (1.0f / 64.0f);
            const float yn = d * (1.0f / sqrtf(var + 64e-5f)) * lg + lb;
            const float res = (yn + bonus * v) * gt * sigmoidf_(gt);
            MX[(size_t)m * DM + c] = (bf16)f2bf(res);
        }
        __syncthreads();
    }
}

__global__ void __launch_bounds__(NTHREADS, 2) fwd_megakernel(Params p) {
    extern __shared__ __attribute__((aligned(16))) unsigned char lds_raw[];
    LAS unsigned char* lds = (LAS unsigned char*)lds_raw;
    cg::grid_group grid = cg::this_grid();
    const int tid = threadIdx.x, lane = tid & 63, wave = __builtin_amdgcn_readfirstlane(tid >> 6);
#ifndef NO_P0
    p0_prologue(p, lds, wave, lane);
#endif
    grid.sync();
#ifndef NO_G1
    { pg8::Gemm g{(const pg8::bf16_t*)p.out, (const pg8::bf16_t*)(p.ws + WS_WINT), M_TOK, DINP, DM};
      pg8::StaticOrder S; S.init(M_TOK, DINP, (int)gridDim.x, (int)blockIdx.x);
      pg8::EpiBf16<0> E{(pg8::bf16_t*)(p.ws + WS_Z), DINP, nullptr, 0, 0};
      pg8::gemm_phase<pg8::EpiBf16<0>, pg8::StaticOrder>((PG8_LAS unsigned char*)lds, g, S, E, nullptr); }
#endif
    grid.sync();
#ifndef NO_QK
    qk_norm_phase(p, wave, lane);
#endif
    grid.sync();
#ifndef NO_NA
    na_phase_simple(p, wave, lane);
#endif
#ifndef NO_SCAN
    scan_phase_simple(p, lds, wave, lane);
#endif
    grid.sync();
#ifndef NO_MIX
    mix_phase(p, lds, wave, lane);
#endif
    grid.sync();
#ifndef NO_G2
    { pg8::Gemm g{(const pg8::bf16_t*)(p.ws + WS_MIXED), (const pg8::bf16_t*)(p.ws + WS_WOUTT), M_TOK, DM, DM};
      pg8::StaticOrder S; S.init(M_TOK, DM, (int)gridDim.x, (int)blockIdx.x);
      pg8::EpiResF32 E{p.x_prompt, p.x_sample, p.out};
      pg8::gemm_phase<pg8::EpiResF32, pg8::StaticOrder>((PG8_LAS unsigned char*)lds, g, S, E, nullptr); }
#endif
}

extern "C" void kernel_launch(void* const* d_in, const int* in_sizes, int n_in, void* d_out, int out_size,
                              void* d_ws, size_t ws_size, hipStream_t stream) {
    static int grid_blocks = 0;
    if (grid_blocks == 0) {
        if (n_in != 18 || out_size != M_TOK * DM || ws_size < WS_END) {
            fprintf(stderr, "kernel_launch: unexpected shapes (n_in %d out %d ws %zu need %zu); nothing launched\n", n_in, out_size, ws_size, (size_t)WS_END);
            grid_blocks = -1; return; }
        int dev = 0, cus = 0, per_cu = 0;
        (void)hipGetDevice(&dev);
        (void)hipDeviceGetAttribute(&cus, hipDeviceAttributeMultiprocessorCount, dev);
        (void)hipFuncSetAttribute((const void*)fwd_megakernel, hipFuncAttributeMaxDynamicSharedMemorySize, LDS_BYTES);
        (void)hipOccupancyMaxActiveBlocksPerMultiprocessor(&per_cu, fwd_megakernel, NTHREADS, LDS_BYTES);
        if (per_cu < 1) { fprintf(stderr, "kernel_launch: occupancy query says %d blocks per CU\n", per_cu); per_cu = 1; }
        grid_blocks = cus;
    }
    if (grid_blocks < 0) return;
    Params p{};
    p.x_prompt = (const float*)d_in[0]; p.x_sample = (const float*)d_in[1]; p.norm_g = (const float*)d_in[2]; p.w_in = (const float*)d_in[3];
    p.shift_mu = (const float*)d_in[4]; p.w0 = (const float*)d_in[5]; p.w_up = (const float*)d_in[6]; p.a0 = (const float*)d_in[7]; p.a_up = (const float*)d_in[8];
    p.k_k = (const float*)d_in[9]; p.k_a = (const float*)d_in[10]; p.r_k = (const float*)d_in[11]; p.lnx_g = (const float*)d_in[12]; p.lnx_b = (const float*)d_in[13];
    p.q_norm_g = (const float*)d_in[14]; p.k_norm_g = (const float*)d_in[15]; p.rpb = (const float*)d_in[16]; p.w_out = (const float*)d_in[17];
    p.out = (float*)d_out; p.ws = (unsigned char*)d_ws;
    void* args[] = {&p};
    hipError_t e = hipLaunchCooperativeKernel((void*)fwd_megakernel, dim3(grid_blocks), dim3(NTHREADS), args, LDS_BYTES, stream);
    if (e != hipSuccess) fprintf(stderr, "cooperative launch failed: %s (grid %d)\n", hipGetErrorString(e), grid_blocks);
}
```

```cpp
#include <hip/hip_runtime.h>
#include <hip/hip_cooperative_groups.h>
#include <cstdio>
#include <cstdint>
namespace cg = cooperative_groups;
#define PROBE_REP_PRE 1
#define PROBE_REP_NA 1
#define PROBE_REP_MIX 1
#define PROBE_REP_P0 1

namespace pg8 {
#define PG8_LAS __attribute__((address_space(3)))
typedef unsigned short bf16_t;
typedef short bf16x8 __attribute__((ext_vector_type(8)));
typedef float f32x4 __attribute__((ext_vector_type(4)));
typedef unsigned u32x4 __attribute__((ext_vector_type(4)));
constexpr int BM = 256, BK = 64, HALF = 128, HTB = HALF * BK * 2  , STAGE_BYTES = 8 * HTB, NXCD = 8, WGM = 8;

__host__ __device__ __forceinline__ int lds_byte(int r, int c) { const int st = (r >> 4) * 2 + (c >> 5), rr = r & 15, cc = c & 31, ob = rr * 64 + cc * 2; return st * 1024 + (ob ^ (((ob >> 9) & 1) << 5)); }
__host__ __device__ __forceinline__ void stage_rc(int b, int& R, int& C) { const int st = b / 1024, sb = b % 1024, swz = sb ^ (((sb >> 9) & 1) << 5); R = (st >> 1) * 16 + swz / 64; C = (st & 1) * 32 + (swz % 64) / 2; }
__host__ __device__ __forceinline__ int perm32(int rho) { const int n = rho >> 4, i = rho & 15; return 8 * (i >> 2) + 4 * n + (i & 3); }

struct Unit { int pm, pn; int half; };
struct Gemm { const bf16_t* A; const bf16_t* Bt; int M, N, K; int lda; const bf16_t* A2; int ksplit; };

struct StaticOrder {
    int nM, nN, nwg, G, c, half_last;
    __host__ __device__ void init(int M, int N, int G_, int c_, int half_last_ = 0) { nM = M / BM; nN = N / BM; nwg = nM * nN; G = G_; c = c_; half_last = half_last_; }
    __host__ __device__ bool next(int i, Unit& u) const {
        const long L = (long)i * G + c; if (L >= nwg) return false;
        int wgid = (int)L; { const int q = nwg / NXCD, r = nwg % NXCD, xcd = wgid % NXCD, off = wgid / NXCD; wgid = (xcd < r ? xcd * (q + 1) : r * (q + 1) + (xcd - r) * q) + off; }
        const int nig = WGM * nN, gid = wgid / nig, fm = gid * WGM, gsz = (nM - fm) < WGM ? (nM - fm) : WGM;
        u.pm = fm + ((wgid % nig) % gsz); u.pn = (wgid % nig) / gsz; u.half = (half_last && u.pn == nN - 1) ? 1 : 0; return true;
    }
    __device__ __forceinline__ void a_ready(const Unit&) const {}
    __device__ __forceinline__ void done(const Unit&) const {}
};
__device__ __forceinline__ unsigned cvt_pk_bf16(float lo, float hi) { unsigned r; asm volatile("v_cvt_pk_bf16_f32 %0, %1, %2" : "=v"(r) : "v"(lo), "v"(hi)); return r; }
typedef float f32x2 __attribute__((ext_vector_type(2)));
__device__ __forceinline__ f32x2 gelu_pk(f32x2 v) {
    const f32x2 av = __builtin_elementwise_abs(v), d = av * 0.2316418882f + 1.0f;
    f32x2 t; t.x = __builtin_amdgcn_rcpf(d.x); t.y = __builtin_amdgcn_rcpf(d.y);
    f32x2 q = t * 0.5307027145f + (-0.7265760135f); q = q * t + 0.7107068705f; q = q * t + (-0.142248368f); q = q * t + 0.127414796f; q = q * t;
    const f32x2 s = (v * v) * (-0.72134752044f);
    f32x2 e; e.x = __builtin_amdgcn_exp2f(s.x); e.y = __builtin_amdgcn_exp2f(s.y);
    const f32x2 m = v * (q * e), r = v - m;
    f32x2 o; o.x = v.x < 0.f ? m.x : r.x; o.y = v.y < 0.f ? m.y : r.y; return o;
}
struct EpiF32 {
    static constexpr bool PERM = false, AFTER_DRAIN = false, SPLIT = false;
    float* C; int ldc; const float* bias;
    __device__ __forceinline__ void operator()(const f32x4 (&acc)[2][2][4][2], const Unit& u, int wr, int wc, int fr, int fq) const {
        const int row0 = u.pm * BM + wr * 64 + fr, col0 = u.pn * BM + wc * 32 + 4 * fq;
        f32x4 bv[2][2];
#pragma unroll
        for (int bj = 0; bj < 2; ++bj)
#pragma unroll
            for (int n = 0; n < 2; ++n) bv[bj][n] = bias ? *(const f32x4*)(bias + col0 + bj * HALF + n * 16) : (f32x4){0.f, 0.f, 0.f, 0.f};
#pragma unroll
        for (int ai = 0; ai < 2; ++ai)
#pragma unroll
            for (int m = 0; m < 4; ++m) { float* rowp = C + (size_t)(row0 + ai * HALF + m * 16) * ldc + col0;
#pragma unroll
                for (int bj = 0; bj < 2; ++bj)
#pragma unroll
                    for (int n = 0; n < 2; ++n) *(f32x4*)(rowp + bj * HALF + n * 16) = acc[ai][bj][m][n] + bv[bj][n]; }
    }
};
template <int ACT  > struct EpiBf16 {
    static constexpr bool PERM = true, AFTER_DRAIN = false, SPLIT = (ACT == 0);
    bf16_t* O; int ldc; const float* bias; int split_cols; size_t split_stride;
    __device__ __forceinline__ void quad(const f32x4 (&acc)[2][2][4][2], const Unit& u, int wr, int wc, int fr, int fq, int ai, int bj) const {
        const int col = u.pn * BM + wc * 32 + 8 * fq + bj * HALF;
        bf16_t* rowp0 = O + (size_t)(col >> 6) * split_stride + (size_t)(u.pm * BM + wr * 64 + fr + ai * HALF) * 64 + (col & 63);
#pragma unroll
        for (int m = 0; m < 4; ++m) { const f32x4 v0 = acc[ai][bj][m][0], v1 = acc[ai][bj][m][1];
            u32x4 w; w.x = cvt_pk_bf16(v0[0], v0[1]); w.y = cvt_pk_bf16(v0[2], v0[3]); w.z = cvt_pk_bf16(v1[0], v1[1]); w.w = cvt_pk_bf16(v1[2], v1[3]);
            *(u32x4*)(rowp0 + (size_t)(m * 16) * 64) = w; }
    }
    __device__ __forceinline__ void operator()(const f32x4 (&acc)[2][2][4][2], const Unit& u, int wr, int wc, int fr, int fq) const {
        const int row0 = u.pm * BM + wr * 64 + fr; int colt = u.pn * BM; bf16_t* base = O;
        if (split_cols) { const int t = colt / split_cols; base += (size_t)t * split_stride; colt -= t * split_cols; }
        const int col0 = colt + wc * 32 + 8 * fq, bcol0 = u.pn * BM + wc * 32 + 8 * fq;
        f32x4 bv[2][2];
#pragma unroll
        for (int bj = 0; bj < 2; ++bj)
#pragma unroll
            for (int n = 0; n < 2; ++n) bv[bj][n] = bias ? *(const f32x4*)(bias + bcol0 + bj * HALF + 4 * n) : (f32x4){0.f, 0.f, 0.f, 0.f};
#pragma unroll
        for (int ai = 0; ai < 2; ++ai)
#pragma unroll
            for (int m = 0; m < 4; ++m) { bf16_t* rowp = base + (size_t)(row0 + ai * HALF + m * 16) * ldc + col0;
#pragma unroll
                for (int bj = 0; bj < 2; ++bj) { if (bj == 1 && u.half) continue;
                    f32x4 v0 = acc[ai][bj][m][0] + bv[bj][0], v1 = acc[ai][bj][m][1] + bv[bj][1];
                    if (ACT == 1) { f32x2 a = gelu_pk((f32x2){v0[0], v0[1]}), b = gelu_pk((f32x2){v0[2], v0[3]}), c = gelu_pk((f32x2){v1[0], v1[1]}), d = gelu_pk((f32x2){v1[2], v1[3]});
                        v0 = (f32x4){a.x, a.y, b.x, b.y}; v1 = (f32x4){c.x, c.y, d.x, d.y}; }
                    if (ACT == 2) {
#pragma unroll
                        for (int j = 0; j < 4; ++j) { v0[j] = 0.5f * v0[j] * (1.0f + erff(v0[j] * 0.70710678f)); v1[j] = 0.5f * v1[j] * (1.0f + erff(v1[j] * 0.70710678f)); } }
                    u32x4 w; w.x = cvt_pk_bf16(v0[0], v0[1]); w.y = cvt_pk_bf16(v0[2], v0[3]); w.z = cvt_pk_bf16(v1[0], v1[1]); w.w = cvt_pk_bf16(v1[2], v1[3]);
                    *(u32x4*)(rowp + bj * HALF) = w; } }
    }
};
struct EpiResF32 {
    static constexpr bool PERM = false, AFTER_DRAIN = false, SPLIT = false;
    const float* xp; const float* xs; float* C;
    __device__ __forceinline__ void operator()(const f32x4 (&acc)[2][2][4][2], const Unit& u, int wr, int wc, int fr, int fq) const {
        const int row0 = u.pm * BM + wr * 64 + fr, col0 = u.pn * BM + wc * 32 + 4 * fq;
        const float* xb = (u.pm < 128 ? xp + (size_t)row0 * 1024 : xs + (size_t)(row0 - 32768) * 1024) + col0;
        float* cb = C + (size_t)row0 * 1024 + col0;
#pragma unroll
        for (int ai = 0; ai < 2; ++ai) {
            f32x4 xv[4][2][2];
#pragma unroll
            for (int m = 0; m < 4; ++m)
#pragma unroll
                for (int bj = 0; bj < 2; ++bj)
#pragma unroll
                    for (int n = 0; n < 2; ++n) xv[m][bj][n] = *(const f32x4*)(xb + (size_t)(ai * HALF + m * 16) * 1024 + bj * HALF + n * 16);
            __builtin_amdgcn_sched_barrier(0);
#pragma unroll
            for (int m = 0; m < 4; ++m)
#pragma unroll
                for (int bj = 0; bj < 2; ++bj)
#pragma unroll
                    for (int n = 0; n < 2; ++n) *(f32x4*)(cb + (size_t)(ai * HALF + m * 16) * 1024 + bj * HALF + n * 16) = acc[ai][bj][m][n] + xv[m][bj][n];
            __builtin_amdgcn_sched_barrier(0);
        }
    }
};
template <class Epi, class Sched, bool STAMP = false>
__device__ __forceinline__ void gemm_phase(PG8_LAS unsigned char* lds, const Gemm g, const Sched& S, const Epi& E, unsigned long long* stamps) {
    int tid_ = threadIdx.x; asm volatile("" : "+v"(tid_));
    const int tid = tid_, wid = __builtin_amdgcn_readfirstlane(tid >> 6), lane = tid & 63, wr = wid >> 2, wc = wid & 3, fr = lane & 15, fq = lane >> 4;
    const int K = g.K, nt = K / BK;
    int ts_lo = 0, ts_hi = 0, nts = 0; const unsigned long long rt_entry = STAMP ? (unsigned long long)wall_clock64() : 0ull;
#define PG8_STAMP() do { if (STAMP && wid == 0 && nts < 64) { const unsigned long long _c = (unsigned long long)clock64(); \
        ts_lo = (lane == nts) ? (int)(unsigned)_c : ts_lo; ts_hi = (lane == nts) ? (int)(unsigned)(_c >> 32) : ts_hi; ++nts; } } while (0)
    PG8_STAMP();
    unsigned voffA[2], voffB[2];
#pragma unroll
    for (int i = 0; i < 2; ++i) { int R, C; stage_rc(tid * 16 + i * 8192, R, C); const int Rb = Epi::PERM ? ((R & ~31) + perm32(R & 31)) : R;
        voffA[i] = (unsigned)(R * g.lda + C) * 2u; voffB[i] = (unsigned)(Rb * K + C) * 2u; }
    const size_t kstep = (size_t)(BK * 2);
    const size_t hstep = (size_t)HALF * K * 2;
    const size_t tstep = 2 * hstep;
    const size_t hstepA = (size_t)HALF * g.lda * 2, tstepA = 2 * hstepA;
    const int ks = g.ksplit;
#define PG8_AK(lo, hi, t) (((t) < ks ? (lo) : (hi)) + (size_t)(t) * kstep)
    const unsigned ldsw = (unsigned)wid * 1024u;
    const int aoff = lds_byte(wr * 64 + fr, fq * 8), boff = lds_byte(wc * 32 + fr, fq * 8);
#define PG8_SA(b, h) (((b) * 2 + (h)) * HTB)
#define PG8_SB(b, h) ((4 + (b) * 2 + (h)) * HTB)
#define PG8_STAGE(bufoff, gbase, voff) do { _Pragma("unroll") for (int _i = 0; _i < 2; ++_i) \
        __builtin_amdgcn_global_load_lds((const unsigned*)((const char*)(gbase) + (voff)[_i]), (PG8_LAS unsigned*)(lds + (bufoff) + ldsw + _i * 8192), 16, 0, 0); } while (0)
#define PG8_LDA(dst, b, h) do { _Pragma("unroll") for (int m = 0; m < 4; ++m) _Pragma("unroll") for (int k = 0; k < 2; ++k) dst[m][k] = *(const PG8_LAS bf16x8*)(lds + PG8_SA(b, h) + aoff + m * 2048 + k * 1024); } while (0)
#define PG8_LDB(dst, b, h) do { _Pragma("unroll") for (int n = 0; n < 2; ++n) _Pragma("unroll") for (int k = 0; k < 2; ++k) dst[n][k] = *(const PG8_LAS bf16x8*)(lds + PG8_SB(b, h) + boff + n * 2048 + k * 1024); } while (0)
#define PG8_MMA(ai, bj, At, Bt) do { __builtin_amdgcn_s_setprio(1); _Pragma("unroll") for (int m = 0; m < 4; ++m) _Pragma("unroll") for (int n = 0; n < 2; ++n) _Pragma("unroll") for (int k = 0; k < 2; ++k) \
        acc[ai][bj][m][n] = __builtin_amdgcn_mfma_f32_16x16x32_bf16(Bt[n][k], At[m][k], acc[ai][bj][m][n], 0, 0, 0); __builtin_amdgcn_s_setprio(0); } while (0)
#define PG8_WAIT_V(n) asm volatile("s_waitcnt vmcnt(" #n ")" ::: "memory")
#define PG8_WAIT_L(n) asm volatile("s_waitcnt lgkmcnt(" #n ")" ::: "memory")
#define PG8_BAR __builtin_amdgcn_s_barrier()
#define PG8_SCHED __builtin_amdgcn_sched_barrier(0)
    Unit cur, nxt; int ui = 0;
    if (!S.next(0, cur)) return;
    f32x4 acc[2][2][4][2];
#pragma unroll
    for (int a = 0; a < 2; ++a)
#pragma unroll
        for (int b = 0; b < 2; ++b)
#pragma unroll
            for (int m = 0; m < 4; ++m)
#pragma unroll
                for (int n = 0; n < 2; ++n) acc[a][b][m][n] = (f32x4){0.f, 0.f, 0.f, 0.f};
    bf16x8 At[4][2], B0[2][2], B1[2][2];
    const char* cA = (const char*)g.A + (size_t)cur.pm * tstepA; const char* cA2 = (const char*)g.A2 + (size_t)cur.pm * tstepA - (size_t)ks * kstep; const char* cB = (const char*)g.Bt + (size_t)cur.pn * tstep;
    S.a_ready(cur);
    PG8_STAGE(PG8_SB(0, 0), cB, voffB); PG8_STAGE(PG8_SA(0, 0), cA, voffA); PG8_STAGE(PG8_SB(0, 1), cB + hstep, voffB); PG8_STAGE(PG8_SA(0, 1), cA + hstepA, voffA);
    if (wr == 1) PG8_BAR;
    PG8_WAIT_V(4); PG8_BAR;
    PG8_STAGE(PG8_SB(1, 0), cB + kstep, voffB); PG8_STAGE(PG8_SA(1, 0), cA + kstep, voffA); PG8_STAGE(PG8_SB(1, 1), cB + hstep + kstep, voffB);
    PG8_WAIT_V(6); PG8_BAR;
    PG8_STAMP();
    for (;;) {
        const bool has_next = S.next(ui + 1, nxt);
        const char* nA = has_next ? (const char*)g.A + (size_t)nxt.pm * tstepA : cA; const char* nA2 = has_next ? (const char*)g.A2 + (size_t)nxt.pm * tstepA - (size_t)ks * kstep : cA2;
        const char* nB = has_next ? (const char*)g.Bt + (size_t)nxt.pn * tstep : cB;
        const bool hb = cur.half != 0;
        for (int t = 0; t < nt; t += 2) {
            const bool last = (t == nt - 2);
            const char* a1 = PG8_AK(cA, cA2, t + 1);
            const char* a2 = last ? nA : PG8_AK(cA, cA2, t + 2); const char* b2 = last ? nB : cB + (size_t)(t + 2) * kstep;
            const char* a3 = a2 + kstep; const char* b3 = b2 + kstep;
            if (last && has_next) S.a_ready(nxt);
            PG8_LDB(B0, 0, 0); PG8_SCHED; PG8_LDA(At, 0, 0); PG8_STAGE(PG8_SA(1, 1), a1 + hstepA, voffA);
            PG8_WAIT_L(8); PG8_BAR; PG8_WAIT_L(0); PG8_MMA(0, 0, At, B0); PG8_BAR; PG8_SCHED;
            PG8_LDB(B1, 0, 1); PG8_STAGE(PG8_SB(0, 0), b2, voffB);
            PG8_BAR; PG8_WAIT_L(0); if (!hb) PG8_MMA(0, 1, At, B1); PG8_BAR;
            PG8_LDA(At, 0, 1); PG8_STAGE(PG8_SA(0, 0), a2, voffA);
            PG8_BAR; PG8_WAIT_L(0); PG8_MMA(1, 0, At, B0); PG8_BAR; PG8_SCHED;
            PG8_STAGE(PG8_SB(0, 1), b2 + hstep, voffB);
            PG8_WAIT_V(6); PG8_BAR; if (!hb) PG8_MMA(1, 1, At, B1); PG8_BAR;
            PG8_LDB(B0, 1, 0); PG8_SCHED; PG8_LDA(At, 1, 0); PG8_STAGE(PG8_SA(0, 1), a2 + hstepA, voffA);
            PG8_WAIT_L(8); PG8_BAR; PG8_WAIT_L(0); PG8_MMA(0, 0, At, B0); PG8_BAR; PG8_SCHED;
            const bool lsp = Epi::SPLIT && last;
            PG8_LDB(B1, 1, 1); PG8_STAGE(PG8_SB(1, 0), b3, voffB);
            if constexpr (Epi::SPLIT) { if (lsp) E.quad(acc, cur, wr, wc, fr, fq, 0, 0); }
            PG8_BAR; PG8_WAIT_L(0); if (!hb) PG8_MMA(0, 1, At, B1); PG8_BAR;
            PG8_LDA(At, 1, 1); PG8_STAGE(PG8_SA(1, 0), a3, voffA);
            if constexpr (Epi::SPLIT) { if (lsp && !hb) E.quad(acc, cur, wr, wc, fr, fq, 0, 1); }
            PG8_BAR; PG8_WAIT_L(0); PG8_MMA(1, 0, At, B0); PG8_BAR; PG8_SCHED;
            PG8_STAGE(PG8_SB(1, 1), b3 + hstep, voffB);
            if constexpr (Epi::SPLIT) { if (lsp) E.quad(acc, cur, wr, wc, fr, fq, 1, 0); }
            if (lsp) { if (hb) PG8_WAIT_V(14); else PG8_WAIT_V(18); } else PG8_WAIT_V(6);
            PG8_BAR; if (!hb) PG8_MMA(1, 1, At, B1); PG8_BAR;
        }
        PG8_STAMP();
        if constexpr (Epi::SPLIT) { if (!hb) E.quad(acc, cur, wr, wc, fr, fq, 1, 1); S.done(cur); }
        else if constexpr (!Epi::AFTER_DRAIN) { E(acc, cur, wr, wc, fr, fq); S.done(cur); }
        PG8_STAMP();
        if (!has_next) break;
#pragma unroll
        for (int a = 0; a < 2; ++a)
#pragma unroll
            for (int b = 0; b < 2; ++b)
#pragma unroll
                for (int m = 0; m < 4; ++m)
#pragma unroll
                    for (int n = 0; n < 2; ++n) acc[a][b][m][n] = (f32x4){0.f, 0.f, 0.f, 0.f};
        cur = nxt; cA = nA; cA2 = nA2; cB = nB; ++ui;
    }
    PG8_WAIT_V(0);
    if (wr == 0) PG8_BAR;
    PG8_BAR;
    if constexpr (Epi::AFTER_DRAIN) { E.fused(acc, cur, wr, wc, fr, fq, lds, wid, lane); S.done(cur); }
    PG8_STAMP();
    if (STAMP && wid == 0) { stamps[lane] = lane < nts ? (((unsigned long long)(unsigned)ts_hi << 32) | (unsigned)ts_lo) : 0ull;
        if (lane == 62) stamps[62] = rt_entry; if (lane == 63) stamps[63] = (unsigned long long)wall_clock64(); }
#undef PG8_STAMP
#undef PG8_AK
#undef PG8_SA
#undef PG8_SB
#undef PG8_STAGE
#undef PG8_LDA
#undef PG8_LDB
#undef PG8_MMA
#undef PG8_WAIT_V
#undef PG8_WAIT_L
#undef PG8_BAR
#undef PG8_SCHED
}
}
#define GAS __attribute__((address_space(1)))
#define LAS __attribute__((address_space(3)))
typedef unsigned short bf16;
typedef float f32x4 __attribute__((ext_vector_type(4)));
typedef unsigned u32x4 __attribute__((ext_vector_type(4)));
typedef unsigned u32x2 __attribute__((ext_vector_type(2)));
constexpr int DM = 1024, M_TOK = 98304, M_PROMPT = 32768, T_PROMPT = 16384, T_SAMPLE = 4096, NSEQ = 18;
constexpr int DIN = 4224, DINP = 4352, DRW = 512, NH = 8, HD = 64;
constexpr int C_R = 0, C_K = 512, C_V = 1024, C_G = 1536, C_WDN = 2048, C_ADN = 2112, C_AQ = 2176, C_AK = 2688, C_AV = 3200, C_AG = 3712;
constexpr int NWAVES = 8, NTHREADS = 512;
constexpr size_t ZSLAB = (size_t)98304 * 64;
#define ZS(Z_, m_, col_) ((Z_) + (size_t)((col_) >> 6) * ZSLAB + (size_t)(m_) * 64 + ((col_) & 63))
constexpr int LDS_BYTES = 163840;
constexpr size_t MiB = 1u << 20;
constexpr size_t WS_CTL = 0;
constexpr size_t WS_WINT = 2 * MiB;
constexpr size_t WS_WOUTT = 11 * MiB;
constexpr size_t WS_WUPT = 13 * MiB;
constexpr size_t WS_AUPT = 13 * MiB + 131072;
constexpr size_t WS_BONUS = 14 * MiB;
constexpr size_t WS_Z = 20 * MiB;
constexpr size_t CMB = (size_t)2 * 1536 * 8 * 8192;
constexpr size_t WS_CM_P = WS_Z + (size_t)M_TOK * DINP * 2;
constexpr size_t WS_CM_RP = WS_CM_P + CMB;
constexpr size_t WS_CM_G = WS_CM_RP + CMB;
constexpr size_t WS_MIXED = WS_CM_P;
constexpr size_t WS_YA = WS_CM_G + CMB;
constexpr size_t WS_LD = WS_YA + (size_t)M_TOK * DRW * 2;
constexpr size_t WS_RN = WS_LD + (size_t)M_TOK * 128 * 2;
constexpr size_t WS_END = WS_RN + (size_t)M_TOK * NH * 4;

struct Params {
    const float* x_prompt; const float* x_sample; const float* norm_g; const float* w_in; const float* shift_mu; const float* w0; const float* w_up;
    const float* a0; const float* a_up; const float* k_k; const float* k_a; const float* r_k; const float* lnx_g; const float* lnx_b;
    const float* q_norm_g; const float* k_norm_g; const float* rpb; const float* w_out;
    float* out; unsigned char* ws;
};

__device__ __forceinline__ unsigned f2bf(float f) { unsigned u = __builtin_bit_cast(unsigned, f); return (u + 0x7fffu + ((u >> 16) & 1u)) >> 16; }
__device__ __forceinline__ unsigned pk2(float lo, float hi) { return f2bf(lo) | (f2bf(hi) << 16); }
__device__ __forceinline__ float bf2f(unsigned b) { return __builtin_bit_cast(float, b << 16); }
__device__ __forceinline__ float bflo(unsigned w) { return __builtin_bit_cast(float, w << 16); }
__device__ __forceinline__ float bfhi(unsigned w) { return __builtin_bit_cast(float, w & 0xffff0000u); }
__device__ __forceinline__ float sigmoidf_(float x) { return 1.0f / (1.0f + __expf(-x)); }
__device__ __forceinline__ float fsigmoid(float x) { return __builtin_amdgcn_rcpf(1.0f + __builtin_amdgcn_exp2f(-1.4426950408889634f * x)); }
__device__ __forceinline__ float dpp_sum16(float v) {
    v += __builtin_bit_cast(float, __builtin_amdgcn_update_dpp(0, __builtin_bit_cast(int, v), 0xB1, 0xF, 0xF, true));
    v += __builtin_bit_cast(float, __builtin_amdgcn_update_dpp(0, __builtin_bit_cast(int, v), 0x4E, 0xF, 0xF, true));
    v += __builtin_bit_cast(float, __builtin_amdgcn_update_dpp(0, __builtin_bit_cast(int, v), 0x141, 0xF, 0xF, true));
    v += __builtin_bit_cast(float, __builtin_amdgcn_update_dpp(0, __builtin_bit_cast(int, v), 0x140, 0xF, 0xF, true));
    return v;
}
__device__ __forceinline__ float dpp_sum8(float v) {
    v += __builtin_bit_cast(float, __builtin_amdgcn_update_dpp(0, __builtin_bit_cast(int, v), 0xB1, 0xF, 0xF, true));
    v += __builtin_bit_cast(float, __builtin_amdgcn_update_dpp(0, __builtin_bit_cast(int, v), 0x4E, 0xF, 0xF, true));
    v += __builtin_bit_cast(float, __builtin_amdgcn_update_dpp(0, __builtin_bit_cast(int, v), 0x141, 0xF, 0xF, true));
    return v;
}
__device__ __forceinline__ float add_xor16(float v) { const auto r = __builtin_amdgcn_permlane16_swap(__float_as_uint(v), __float_as_uint(v), false, false); return __uint_as_float(r[0]) + __uint_as_float(r[1]); }
__device__ __forceinline__ float add_xor32(float v) { const auto r = __builtin_amdgcn_permlane32_swap(__float_as_uint(v), __float_as_uint(v), false, false); return __uint_as_float(r[0]) + __uint_as_float(r[1]); }
__device__ __forceinline__ float wave_sum(float v) { return add_xor32(add_xor16(dpp_sum16(v))); }
__device__ __forceinline__ float max_xor16(float v) { const auto r = __builtin_amdgcn_permlane16_swap(__float_as_uint(v), __float_as_uint(v), false, false); return fmaxf(__uint_as_float(r[0]), __uint_as_float(r[1])); }
__device__ __forceinline__ float max_xor32(float v) { const auto r = __builtin_amdgcn_permlane32_swap(__float_as_uint(v), __float_as_uint(v), false, false); return fmaxf(__uint_as_float(r[0]), __uint_as_float(r[1])); }
__device__ __forceinline__ float dpp_rs16x4(float a0, float a1, float a2, float a3, int cl) {
#define DPPF(x, ctrl) __builtin_bit_cast(float, __builtin_amdgcn_update_dpp(0, __builtin_bit_cast(int, (x)), (ctrl), 0xF, 0xF, true))
    const bool p0 = (cl & 1) != 0, p1 = (cl & 2) != 0;
    const float k0 = p0 ? a2 : a0, k1 = p0 ? a3 : a1, s0 = p0 ? a0 : a2, s1 = p0 ? a1 : a3;
    const float b0 = k0 + DPPF(s0, 0xB1), b1 = k1 + DPPF(s1, 0xB1);
    const float k = p1 ? b1 : b0, sx = p1 ? b0 : b1;
    float c = k + DPPF(sx, 0x4E);
    c += DPPF(c, 0x124);
    c += DPPF(c, 0x128);
#undef DPPF
    return c;
}
__device__ __forceinline__ void seq_of_token(int m, int& t, int& T) { if (m < M_PROMPT) { t = m & (T_PROMPT - 1); T = T_PROMPT; } else { t = (m - M_PROMPT) & (T_SAMPLE - 1); T = T_SAMPLE; } }
__device__ __forceinline__ void seq_info(int s, int& start, int& len) { if (s < 2) { start = s * T_PROMPT; len = T_PROMPT; } else { start = M_PROMPT + (s - 2) * T_SAMPLE; len = T_SAMPLE; } }

#define XB_TMO      128
#define XB_XCNT(j)  (256  + 64 * (j))
#define XB_XSUB(j)  (1280 + 64 * (j))
#define XB_XGEN(j)  (2304 + 64 * (j))
#define XB_TOP      3328
#define XB_TOPGEN   3392
#define XCD_BAR_WORDS 3456
#define XB_SPIN_CAP (1u << 18)

__device__ __forceinline__ unsigned xb_ld(unsigned* p)              { return __hip_atomic_load(p, __ATOMIC_RELAXED, __HIP_MEMORY_SCOPE_AGENT); }
__device__ __forceinline__ unsigned xb_add(unsigned* p, unsigned v) { return __hip_atomic_fetch_add(p, v, __ATOMIC_RELAXED, __HIP_MEMORY_SCOPE_AGENT); }
__device__ __forceinline__ unsigned xb_xcc_id() { return (unsigned)__builtin_amdgcn_s_getreg((3 << 11) | 20) & 0xFu; }
#define XB_SPIN(cond, bar) do { unsigned _sp = 0; while (cond) { __builtin_amdgcn_s_sleep(1); \
    if ((++_sp & 255u) == 0u) { if (xb_ld(&(bar)[XB_TMO])) break; if (_sp > XB_SPIN_CAP) { atomicAdd(&(bar)[XB_TMO], 1u); break; } } } } while (0)

struct XcdBarrier {
    unsigned* bar; unsigned x;
    volatile LAS unsigned* st;
};

__device__ __forceinline__ XcdBarrier xcd_barrier_post(unsigned* bar, volatile LAS unsigned* st) {
    XcdBarrier b; b.bar = bar; b.x = xb_xcc_id(); b.st = st;
    if (threadIdx.x == 0) (void)xb_add(&bar[XB_XCNT(b.x)], 1u);
    return b;
}
__device__ __forceinline__ void xcd_barrier_complete(unsigned* bar, unsigned x, unsigned& nloc, unsigned& nx) {
    const unsigned G = gridDim.x * gridDim.y * gridDim.z;
    unsigned sum, cnt, mine, sp = 0u;
    for (;;) {
        sum = 0u; cnt = 0u; mine = 0u;
#pragma unroll
        for (unsigned j = 0; j < 16; ++j) { const unsigned c = xb_ld(&bar[XB_XCNT(j)]); sum += c; cnt += (c > 0u) ? 1u : 0u; mine = (j == x) ? c : mine; }
        if (sum == G) break;
        __builtin_amdgcn_s_sleep(1);
        if ((++sp & 255u) == 0u) { if (xb_ld(&bar[XB_TMO])) break; if (sp > XB_SPIN_CAP) { atomicAdd(&bar[XB_TMO], 1u); break; } }
    }
    nloc = mine > 0u ? mine : 1u; nx = cnt > 0u ? cnt : 1u;
}

__device__ __forceinline__ void xcd_barrier(const XcdBarrier& b) {
    asm volatile("s_waitcnt vmcnt(0)" ::: "memory");
    __syncthreads();
    if (threadIdx.x == 0) {
        unsigned* bar = b.bar;
        __builtin_amdgcn_s_waitcnt(0);
        unsigned nloc = b.st[0], nx = b.st[1];
        if (nloc == 0u) { xcd_barrier_complete(bar, b.x, nloc, nx); b.st[0] = nloc; b.st[1] = nx; }
        const unsigned old = xb_add(&bar[XB_XSUB(b.x)], 1u);
        const unsigned gen = old / nloc;
        if (old + 1u == (gen + 1u) * nloc) {
            __builtin_amdgcn_fence(__ATOMIC_RELEASE, "agent");
            asm volatile("s_waitcnt vmcnt(0)" ::: "memory");
            const unsigned og = xb_add(&bar[XB_TOP], 1u);
            const unsigned tg = og / nx;
            if (og + 1u == (tg + 1u) * nx) xb_add(&bar[XB_TOPGEN], 1u);
            else XB_SPIN(xb_ld(&bar[XB_TOPGEN]) == tg, bar);
            __builtin_amdgcn_fence(__ATOMIC_ACQUIRE, "agent");
            xb_add(&bar[XB_XGEN(b.x)], 1u);
            asm volatile("s_waitcnt vmcnt(0)" ::: "memory");
        } else {
            XB_SPIN(xb_ld(&bar[XB_XGEN(b.x)]) == gen, bar);
            __builtin_amdgcn_fence(__ATOMIC_ACQUIRE, "agent");
            asm volatile("s_waitcnt vmcnt(0)" ::: "memory");
        }
    }
    __syncthreads();
}


__device__ __forceinline__ void p0_transpose_item(const float* W, int K, int N, bf16* WT, LAS float* scr, int item, int lane) {
    const int nblk = N / 32, kb = item / nblk, nb = item % nblk, k0 = 64 * kb, n0 = 32 * nb;
    float wv[32];
#pragma unroll
    for (int i = 0; i < 32; ++i) { const int kk = 2 * i + (lane >> 5); wv[i] = W[(size_t)(k0 + kk) * N + n0 + (lane & 31)]; }
#pragma unroll
    for (int i = 0; i < 32; ++i) { const int kk = 2 * i + (lane >> 5); scr[kk * 33 + (lane & 31)] = wv[i]; }
    asm volatile("s_waitcnt lgkmcnt(0)" ::: "memory");
    const int c = lane & 7;
#pragma unroll
    for (int j = 0; j < 4; ++j) { const int n = (lane >> 3) + 8 * j; const LAS float* s = scr + (8 * c) * 33 + n;
        u32x4 o; o.x = pk2(s[0 * 33], s[1 * 33]); o.y = pk2(s[2 * 33], s[3 * 33]); o.z = pk2(s[4 * 33], s[5 * 33]); o.w = pk2(s[6 * 33], s[7 * 33]);
        *(u32x4*)(WT + (size_t)(n0 + n) * K + k0 + 8 * c) = o; }
    asm volatile("s_waitcnt lgkmcnt(0)" ::: "memory");
}
__device__ __forceinline__ void p0_prologue(const Params& p, LAS unsigned char* lds, int wave, int lane) {
    LAS float* scr = (LAS float*)(lds + wave * 16384);
    const int gw = blockIdx.x * NWAVES + wave, NGW = gridDim.x * NWAVES;
    bf16* WinT = (bf16*)(p.ws + WS_WINT); bf16* WoutT = (bf16*)(p.ws + WS_WOUTT);
    constexpr int I_IN = (DM / 64) * (DIN / 32), I_OUT = (DM / 64) * (DM / 32);
    for (int it = gw; it < I_IN + I_OUT; it += NGW) {
        if (it < I_IN) p0_transpose_item(p.w_in, DM, DIN, WinT, scr, it, lane);
        else p0_transpose_item(p.w_out, DM, DM, WoutT, scr, it - I_IN, lane);
    }
    { bf16* wupT = (bf16*)(p.ws + WS_WUPT); bf16* aupT = (bf16*)(p.ws + WS_AUPT);
      for (int idx = gw * 64 + lane; idx < 2 * DRW * 64; idx += NGW * 64) {
          const int z = idx >> 15, rem = idx & 32767, hc = rem >> 6, l = rem & 63;
          wupT[idx] = (bf16)f2bf(-1.4426950408889634f * p.w_up[(size_t)(z * 64 + l) * DRW + hc]); aupT[idx] = (bf16)f2bf(-1.4426950408889634f * p.a_up[(size_t)(z * 64 + l) * DRW + hc]); } }
    { const size_t n16 = (size_t)(DINP - DIN) * DM * 2 / 16; u32x4* z = (u32x4*)(WinT + (size_t)DIN * DM);
      for (size_t i = (size_t)gw * 64 + lane; i < n16; i += (size_t)NGW * 64) z[i] = (u32x4){0u, 0u, 0u, 0u}; }
    bf16* Hb = (bf16*)p.out;
    const f32x4* gr = (const f32x4*)p.norm_g + lane;
    f32x4 gv[4];
#pragma unroll
    for (int j = 0; j < 4; ++j) gv[j] = gr[64 * j];
    for (int m = gw; m < M_TOK; m += NGW) {
        const float* xrow = (m < M_PROMPT) ? p.x_prompt + (size_t)m * DM : p.x_sample + (size_t)(m - M_PROMPT) * DM;
        const f32x4* xr = (const f32x4*)xrow + lane;
        f32x4 v[4]; float s = 0.f;
#pragma unroll
        for (int j = 0; j < 4; ++j) { v[j] = xr[64 * j]; s += (v[j].x * v[j].x + v[j].y * v[j].y) + (v[j].z * v[j].z + v[j].w * v[j].w); }
        const float rstd = 1.0f / sqrtf(wave_sum(s) * (1.0f / DM) + 1e-6f);
        unsigned long long* o8 = (unsigned long long*)(Hb + (size_t)m * DM) + lane;
#pragma unroll
        for (int j = 0; j < 4; ++j) { const f32x4 w = v[j] * rstd * gv[j]; o8[64 * j] = (unsigned long long)pk2(w.x, w.y) | ((unsigned long long)pk2(w.z, w.w) << 32); }
    }
}

__device__ __forceinline__ void qk_norm_phase(const Params& p, int wave, int lane) {
    const int gw = blockIdx.x * NWAVES + wave, NGW = gridDim.x * NWAVES;
    bf16* Z = (bf16*)(p.ws + WS_Z);
    const int sub = lane & 7, head = lane >> 3;
    float gq[8], gk[8];
#pragma unroll
    for (int i = 0; i < 8; ++i) { gq[i] = p.q_norm_g[sub * 8 + i] * 0.125f; gk[i] = p.k_norm_g[sub * 8 + i]; }
    for (int m = gw; m < M_TOK; m += NGW) {
#pragma unroll
        for (int which = 0; which < 2; ++which) {
            u32x4* ptr = (u32x4*)(Z + (size_t)m * DINP + (which ? C_AK : C_AQ) + head * 64 + sub * 8);
            const u32x4 w = *ptr;
            float f[8] = {bflo(w.x), bfhi(w.x), bflo(w.y), bfhi(w.y), bflo(w.z), bfhi(w.z), bflo(w.w), bfhi(w.w)};
            float ss = 0.f;
#pragma unroll
            for (int i = 0; i < 8; ++i) ss += f[i] * f[i];
            ss += __shfl_xor(ss, 1); ss += __shfl_xor(ss, 2); ss += __shfl_xor(ss, 4);
            const float rstd = 1.0f / sqrtf(ss * (1.0f / 64.0f) + 1e-6f);
#pragma unroll
            for (int i = 0; i < 8; ++i) f[i] = f[i] * rstd * (which ? gk[i] : gq[i]);
            u32x4 o; o.x = pk2(f[0], f[1]); o.y = pk2(f[2], f[3]); o.z = pk2(f[4], f[5]); o.w = pk2(f[6], f[7]);
            *ptr = o;
        }
    }
}

__device__ __forceinline__ void na_phase_simple(const Params& p, int wave, int lane) {
    const int gw = blockIdx.x * NWAVES + wave, NGW = gridDim.x * NWAVES;
    const bf16* Z = (const bf16*)(p.ws + WS_Z);
    bf16* YAo = (bf16*)(p.ws + WS_YA);
    constexpr int NROWS = 2 * (T_PROMPT / 64) + 16 * (T_SAMPLE / 64);
    for (int item = gw; item < NROWS * NH; item += NGW) {
        const int head = item & 7, rowg = item >> 3;
        int seq, r, rows;
        if (rowg < 512) { seq = rowg >> 8; r = rowg & 255; rows = 256; } else { const int rr = rowg - 512; seq = 2 + (rr >> 6); r = rr & 63; rows = 64; }
        int start, len; seq_info(seq, start, len);
        const int mq = start + r * 64 + lane;
        u32x4 qv[8];
        { const u32x4* qp = (const u32x4*)(Z + (size_t)mq * DINP + C_AQ + head * 64);
#pragma unroll
          for (int i = 0; i < 8; ++i) qv[i] = qp[i]; }
        int kr0 = r - 4; kr0 = kr0 < 0 ? 0 : (kr0 > rows - 8 ? rows - 8 : kr0);
        int cs = lane - 8; cs = cs < 0 ? 0 : (cs > 48 ? 48 : cs);
        float o[64];
#pragma unroll
        for (int d = 0; d < 64; ++d) o[d] = 0.f;
        float mrun = -1e30f, lsum = 0.f;
        for (int kr = 0; kr < 8; ++kr) {
            const float* bias_row = p.rpb + ((size_t)head * 15 + (kr0 + kr - r + 7)) * 31 + (cs - lane + 15);
            const bf16* krow = Z + (size_t)(start + (kr0 + kr) * 64 + cs) * DINP + head * 64;
#pragma unroll 1
            for (int j = 0; j < 16; ++j) {
                const u32x4* kp = (const u32x4*)(krow + (size_t)j * DINP + C_AK);
                float s = 0.f;
#pragma unroll
                for (int i = 0; i < 8; ++i) { const u32x4 kv = kp[i];
                    s += bflo(qv[i].x) * bflo(kv.x) + bfhi(qv[i].x) * bfhi(kv.x) + bflo(qv[i].y) * bflo(kv.y) + bfhi(qv[i].y) * bfhi(kv.y)
                       + bflo(qv[i].z) * bflo(kv.z) + bfhi(qv[i].z) * bfhi(kv.z) + bflo(qv[i].w) * bflo(kv.w) + bfhi(qv[i].w) * bfhi(kv.w); }
                s += bias_row[j];
                const float mnew = fmaxf(mrun, s);
                const float alpha = __expf(mrun - mnew);
                const float pj = __expf(s - mnew);
                mrun = mnew;
                lsum = lsum * alpha + pj;
                const u32x4* vp = (const u32x4*)(krow + (size_t)j * DINP + C_AV);
#pragma unroll
                for (int i = 0; i < 8; ++i) { const u32x4 vv = vp[i];
                    o[8 * i + 0] = o[8 * i + 0] * alpha + pj * bflo(vv.x); o[8 * i + 1] = o[8 * i + 1] * alpha + pj * bfhi(vv.x);
                    o[8 * i + 2] = o[8 * i + 2] * alpha + pj * bflo(vv.y); o[8 * i + 3] = o[8 * i + 3] * alpha + pj * bfhi(vv.y);
                    o[8 * i + 4] = o[8 * i + 4] * alpha + pj * bflo(vv.z); o[8 * i + 5] = o[8 * i + 5] * alpha + pj * bfhi(vv.z);
                    o[8 * i + 6] = o[8 * i + 6] * alpha + pj * bflo(vv.w); o[8 * i + 7] = o[8 * i + 7] * alpha + pj * bfhi(vv.w); }
            }
        }
        const float inv = 1.0f / lsum;
        const u32x4* gp = (const u32x4*)(Z + (size_t)mq * DINP + C_AG + head * 64);
        u32x4* op = (u32x4*)(YAo + (size_t)mq * DRW + head * 64);
#pragma unroll
        for (int i = 0; i < 8; ++i) { const u32x4 gv = gp[i];
            const float g[8] = {bflo(gv.x), bfhi(gv.x), bflo(gv.y), bfhi(gv.y), bflo(gv.z), bfhi(gv.z), bflo(gv.w), bfhi(gv.w)};
            float r8[8];
#pragma unroll
            for (int e = 0; e < 8; ++e) r8[e] = o[8 * i + e] * inv * g[e] * sigmoidf_(g[e]);
            u32x4 w; w.x = pk2(r8[0], r8[1]); w.y = pk2(r8[2], r8[3]); w.z = pk2(r8[4], r8[5]); w.w = pk2(r8[6], r8[7]);
            op[i] = w; }
    }
}

constexpr int SB = 32;
constexpr int ZS_OFF = 0, ZS_BYTES = SB * 320 * 4;
constexpr int BUF_OFF = ZS_BYTES, BUF_BYTES = 6 * SB * 64 * 4;
static_assert(BUF_OFF + 2 * BUF_BYTES <= LDS_BYTES, "scan LDS");
__device__ __forceinline__ void scan_chain_simple(const Params& p, LAS unsigned char* lds, int z, int seq, int h, int wave, int lane) {
    const bf16* Z = (const bf16*)(p.ws + WS_Z);
    float* Y = p.out + (size_t)z * M_TOK * DRW;
    int start, T; seq_info(seq, start, T);
    const int nblk = T / SB;
    LAS float* zs = (LAS float*)(lds + ZS_OFF);
    float S[64];
#pragma unroll
    for (int k = 0; k < 64; ++k) S[k] = 0.f;
    const int hc = h * 64 + lane;
    const float w0c = p.w0[z * DRW + hc], a0c = p.a0[z * DRW + hc], kkc = p.k_k[hc], kac = p.k_a[hc];
    const float* wup = p.w_up + (size_t)z * 64 * DRW + hc;
    const float* aup = p.a_up + (size_t)z * 64 * DRW + hc;
    for (int nb = -1; nb < nblk; ++nb) {
        if (nb + 1 < nblk) {
            for (int e = threadIdx.x; e < SB * 320; e += NTHREADS) {
                const int tok = e / 320, col = e - tok * 320, seg = col >> 6, j = col & 63;
                const int zcol = seg < 3 ? (seg * 512 + h * 64 + j) : (C_WDN + (seg - 3) * 64 + j);
                const int pos = (nb + 1) * SB + tok, t = z ? (T - 1 - pos) : pos;
                const bf16* zp = Z + (size_t)(start + t) * DINP + zcol;
                const float u0 = bf2f(zp[0]);
                const float um = t > 0 ? bf2f(zp[-DINP]) : 0.f;
                const float up = t < T - 1 ? bf2f(zp[DINP]) : 0.f;
                float val = u0 + p.shift_mu[zcol] * (0.5f * (um + up) - u0);
                if (seg == 3) val = tanhf(val);
                zs[e] = val;
            }
        }
        __syncthreads();
        if (wave > 0) {
            if (nb + 1 < nblk) {
                LAS float* ob = (LAS float*)(lds + BUF_OFF + ((nb + 1) & 1) * BUF_BYTES);
                for (int tok = wave - 1; tok < SB; tok += 7) {
                    const LAS float* zr = zs + tok * 320;
                    float wl = 0.f, al = 0.f;
#pragma unroll 8
                    for (int l = 0; l < 64; ++l) { wl += zr[192 + l] * wup[(size_t)l * DRW]; al += zr[256 + l] * aup[(size_t)l * DRW]; }
                    const float xw = w0c + wl;
                    const float sp = fmaxf(-xw, 0.f) + log1pf(__expf(-fabsf(xw)));
                    const float decay = __expf(-__expf(-sp - 0.5f));
                    const float a = sigmoidf_(a0c + al);
                    const float r = zr[lane], k = zr[64 + lane], v = zr[128 + lane];
                    const float kkr = k * kkc;
                    const float nrm = sqrtf(wave_sum(kkr * kkr));
                    const float kk = kkr / fmaxf(nrm, 1e-12f);
                    ob[0 * SB * 64 + tok * 64 + lane] = r;
                    ob[1 * SB * 64 + tok * 64 + lane] = decay;
                    ob[2 * SB * 64 + tok * 64 + lane] = k * (1.0f + (a - 1.0f) * kac);
                    ob[3 * SB * 64 + tok * 64 + lane] = v;
                    ob[4 * SB * 64 + tok * 64 + lane] = kk;
                    ob[5 * SB * 64 + tok * 64 + lane] = kk * a;
                }
            }
        } else if (nb >= 0) {
            const LAS float* ib = (const LAS float*)(lds + BUF_OFF + (nb & 1) * BUF_BYTES);
            for (int tok = 0; tok < SB; ++tok) {
                const LAS f32x4* r4 = (const LAS f32x4*)(ib + 0 * SB * 64 + tok * 64);
                const LAS f32x4* w4 = (const LAS f32x4*)(ib + 1 * SB * 64 + tok * 64);
                const LAS f32x4* k4 = (const LAS f32x4*)(ib + 2 * SB * 64 + tok * 64);
                const LAS f32x4* kk4 = (const LAS f32x4*)(ib + 4 * SB * 64 + tok * 64);
                const LAS f32x4* ka4 = (const LAS f32x4*)(ib + 5 * SB * 64 + tok * 64);
                const float vi = ib[3 * SB * 64 + tok * 64 + lane];
                float skk0 = 0.f, skk1 = 0.f, skk2 = 0.f, skk3 = 0.f;
#pragma unroll
                for (int q = 0; q < 16; ++q) { const f32x4 c = kk4[q]; skk0 += S[4 * q] * c.x; skk1 += S[4 * q + 1] * c.y; skk2 += S[4 * q + 2] * c.z; skk3 += S[4 * q + 3] * c.w; }
                const float nskk = -((skk0 + skk1) + (skk2 + skk3));
                float y0 = 0.f, y1 = 0.f, y2 = 0.f, y3 = 0.f;
#pragma unroll
                for (int q = 0; q < 16; ++q) { const f32x4 wv = w4[q], kv = k4[q], av = ka4[q], rv = r4[q];
                    S[4 * q + 0] = S[4 * q + 0] * wv.x + (vi * kv.x + nskk * av.x); y0 += S[4 * q + 0] * rv.x;
                    S[4 * q + 1] = S[4 * q + 1] * wv.y + (vi * kv.y + nskk * av.y); y1 += S[4 * q + 1] * rv.y;
                    S[4 * q + 2] = S[4 * q + 2] * wv.z + (vi * kv.z + nskk * av.z); y2 += S[4 * q + 2] * rv.z;
                    S[4 * q + 3] = S[4 * q + 3] * wv.w + (vi * kv.w + nskk * av.w); y3 += S[4 * q + 3] * rv.w; }
                const int pos = nb * SB + tok, t = z ? (T - 1 - pos) : pos;
                Y[(size_t)(start + t) * DRW + hc] = (y0 + y1) + (y2 + y3);
            }
        }
        __syncthreads();
    }
}
__device__ __forceinline__ void scan_phase_simple(const Params& p, LAS unsigned char* lds, int wave, int lane) {
    const int b = blockIdx.x;
    if (b < 32) { scan_chain_simple(p, lds, b & 1, b >> 4, (b >> 1) & 7, wave, lane); }
    else {
        for (int q = b - 32; q < 256; q += (int)gridDim.x - 32) scan_chain_simple(p, lds, q & 1, 2 + (q >> 4), (q >> 1) & 7, wave, lane);
    }
}

__device__ __forceinline__ void mix_phase(const Params& p, LAS unsigned char* lds, int wave, int lane) {
    const bf16* Z = (const bf16*)(p.ws + WS_Z);
    bf16* MX = (bf16*)(p.ws + WS_MIXED);
    const float* Yf = p.out; const float* Yb = p.out + (size_t)M_TOK * DRW;
    LAS float* adn = (LAS float*)lds;
    const int c = threadIdx.x;
    float au0[64], au1[64];
#pragma unroll
    for (int l = 0; l < 64; ++l) { au0[l] = p.a_up[(size_t)l * DRW + c]; au1[l] = p.a_up[(size_t)(64 + l) * DRW + c]; }
    const float mu_r = p.shift_mu[C_R + c], mu_k = p.shift_mu[C_K + c], mu_v = p.shift_mu[C_V + c], mu_g = p.shift_mu[C_G + c];
    const float a00 = p.a0[c], a01 = p.a0[DRW + c], kac = p.k_a[c], rkc = p.r_k[c], lg = p.lnx_g[c], lb = p.lnx_b[c];
    const int tk_s = threadIdx.x >> 6, l_s = threadIdx.x & 63;
    const float mu_a = p.shift_mu[C_ADN + l_s];
    for (int g = blockIdx.x; g < M_TOK / 8; g += gridDim.x) {
        { const int m = g * 8 + tk_s; int t, T; seq_of_token(m, t, T);
          const bf16* zp = Z + (size_t)m * DINP + C_ADN + l_s;
          const float u0 = bf2f(zp[0]), um = t > 0 ? bf2f(zp[-DINP]) : 0.f, up = t < T - 1 ? bf2f(zp[DINP]) : 0.f;
          adn[tk_s * 64 + l_s] = u0 + mu_a * (0.5f * (um + up) - u0); }
        __syncthreads();
        for (int tk = 0; tk < 8; ++tk) {
            const int m = g * 8 + tk; int t, T; seq_of_token(m, t, T);
            const bf16* zp = Z + (size_t)m * DINP + c;
            const bool hp = t > 0, hn = t < T - 1;
            float r0 = bf2f(zp[C_R]), k0 = bf2f(zp[C_K]), v0 = bf2f(zp[C_V]), g0 = bf2f(zp[C_G]);
            float rm = hp ? bf2f(zp[C_R - DINP]) : 0.f, km = hp ? bf2f(zp[C_K - DINP]) : 0.f, vm = hp ? bf2f(zp[C_V - DINP]) : 0.f, gm = hp ? bf2f(zp[C_G - DINP]) : 0.f;
            float rp = hn ? bf2f(zp[C_R + DINP]) : 0.f, kp = hn ? bf2f(zp[C_K + DINP]) : 0.f, vp = hn ? bf2f(zp[C_V + DINP]) : 0.f, gp = hn ? bf2f(zp[C_G + DINP]) : 0.f;
            const float r = r0 + mu_r * (0.5f * (rm + rp) - r0), k = k0 + mu_k * (0.5f * (km + kp) - k0);
            const float v = v0 + mu_v * (0.5f * (vm + vp) - v0), gt = g0 + mu_g * (0.5f * (gm + gp) - g0);
            float al0 = a00, al1 = a01;
            const LAS f32x4* ad4 = (const LAS f32x4*)(adn + tk * 64);
#pragma unroll
            for (int q = 0; q < 16; ++q) { const f32x4 a4 = ad4[q];
                al0 += a4.x * au0[4 * q] + a4.y * au0[4 * q + 1] + a4.z * au0[4 * q + 2] + a4.w * au0[4 * q + 3];
                al1 += a4.x * au1[4 * q] + a4.y * au1[4 * q + 1] + a4.z * au1[4 * q + 2] + a4.w * au1[4 * q + 3]; }
            const float as = sigmoidf_(al0) + sigmoidf_(al1);
            const float ksum = k * (2.0f + (as - 2.0f) * kac);
            const float bonus = wave_sum(r * rkc * ksum);
            const float y = Yf[(size_t)m * DRW + c] + Yb[(size_t)m * DRW + c];
            const float mean = wave_sum(y) * (1.0f / 64.0f);
            const float d = y - mean;
            const float var = wave_sum(d * d) * (1.0f / 64.0f);
            const float yn = d * (1.0f / sqrtf(var + 64e-5f)) * lg + lb;
            const float res = (yn + bonus * v) * gt * sigmoidf_(gt);
            MX[(size_t)m * DM + c] = (bf16)f2bf(res);
        }
        __syncthreads();
    }
}

typedef short bf16x8 __attribute__((ext_vector_type(8)));
typedef short s16x4 __attribute__((ext_vector_type(4)));
typedef float f32x16 __attribute__((ext_vector_type(16)));
typedef float f32x2v __attribute__((ext_vector_type(2)));
typedef __bf16 bf16x2_t __attribute__((ext_vector_type(2)));
#define MFMA32(a, b, c) __builtin_amdgcn_mfma_f32_32x32x16_bf16((a), (b), (c), 0, 0, 0)
#define MFMA16(a, b, c) __builtin_amdgcn_mfma_f32_16x16x32_bf16((a), (b), (c), 0, 0, 0)
__device__ __forceinline__ unsigned cvt2(float lo, float hi) { f32x2v v = {lo, hi}; return __builtin_bit_cast(unsigned, __builtin_convertvector(v, bf16x2_t)); }
__device__ __forceinline__ bf16x8 mk8(unsigned a, unsigned b, unsigned c, unsigned d) { u32x4 v = {a, b, c, d}; return __builtin_bit_cast(bf16x8, v); }
__device__ __forceinline__ bf16x8 neg8(bf16x8 x) { u32x4 v = __builtin_bit_cast(u32x4, x); v.x ^= 0x80008000u; v.y ^= 0x80008000u; v.z ^= 0x80008000u; v.w ^= 0x80008000u; return __builtin_bit_cast(bf16x8, v); }
__device__ __forceinline__ bf16x8 pack32(const f32x16& x, int s) {
    return mk8(cvt2(x[8 * s + 0], x[8 * s + 1]), cvt2(x[8 * s + 2], x[8 * s + 3]), cvt2(x[8 * s + 4], x[8 * s + 5]), cvt2(x[8 * s + 6], x[8 * s + 7]));
}
__device__ __forceinline__ unsigned sw_addr(unsigned base, int row, int kbyte) { return base + row * 128 + ((((kbyte >> 4) ^ (row >> 1)) & 7) << 4) + (kbyte & 15); }
struct LdsA {
    unsigned v32;
    unsigned vp;
    unsigned v16;
    unsigned vc;
    unsigned vt;
    unsigned raw;
};
__device__ __forceinline__ LdsA make_ldsa(unsigned grp_base, int w, int lane) {
    LdsA a; const int l31 = lane & 31, hh = lane >> 5, sw = (l31 >> 1) & 7, l15 = lane & 15, tq = lane >> 4, sw16 = l15 >> 1;
    a.raw = grp_base;
    a.v32 = grp_base + l31 * 128 + ((hh ^ sw) << 4);
    a.vp = grp_base + l31 * 128 + (sw << 4) + 8 * hh;
    a.v16 = grp_base + l15 * 128 + ((tq ^ sw16) << 4);
    const int c = 16 * w + l15;
    a.vc = grp_base + c * 128 + (((tq >> 1) ^ ((l15 >> 1) & 7)) << 4) + 8 * (tq & 1);
    a.vt = grp_base + 512 * tq + ((((2 * w + (l15 >> 3)) ^ (2 * tq)) & 7) << 4) + 2 * (l15 & 7);
    return a;
}
__device__ __forceinline__ LAS unsigned char* ldsptr(unsigned a) { return (LAS unsigned char*)(size_t)a; }
__device__ __forceinline__ bf16x8 ld_frag32(const LdsA& A, unsigned slot, int row0, int k0) {
    return *(const LAS bf16x8*)ldsptr((A.v32 ^ (unsigned)(k0 * 2)) + slot + row0 * 128);
}
__device__ __forceinline__ bf16x8 ld_frag32p(const LdsA& A, unsigned slot, int row0, int k0) {
    const u32x2 a = *(const LAS u32x2*)ldsptr((A.vp ^ (unsigned)(k0 * 2)) + slot + row0 * 128);
    const u32x2 b = *(const LAS u32x2*)ldsptr((A.vp ^ (unsigned)(k0 * 2 + 16)) + slot + row0 * 128);
    return mk8(a.x, a.y, b.x, b.y);
}
__device__ __forceinline__ bf16x8 ld_frag16(const LdsA& A, unsigned slot, int row0, int k0) {
    return *(const LAS bf16x8*)ldsptr((A.v16 ^ (unsigned)(k0 * 2)) + slot + row0 * 128);
}
__device__ __forceinline__ void write_c(const LdsA& A, unsigned slot, const f32x16& acc, int row_off, int col_off) {
#pragma unroll
    for (int g = 0; g < 4; ++g) {
        u32x2 v; v.x = cvt2(acc[4 * g], acc[4 * g + 1]); v.y = cvt2(acc[4 * g + 2], acc[4 * g + 3]);
        *(LAS u32x2*)ldsptr((A.vp ^ (unsigned)((row_off / 8 + g) << 4)) + slot + col_off * 128) = v;
    }
}
__device__ __forceinline__ int crow32(int reg, int hh) { return (reg & 3) + 8 * (reg >> 2) + 4 * hh; }
__device__ __forceinline__ int pi_perm(int c) { return (c & 32) + 8 * ((c >> 2) & 3) + 4 * ((c >> 4) & 1) + (c & 3); }

constexpr int GRP_BYTES = 77824;
constexpr unsigned SL_QTT = 0, SL_BCT = 8192, SL_KCT = 16384, SL_RTT = 24576, SL_QTC = 32768, SL_TR = 40960, SL_BHC = 49152, SL_KHC = 57344, SL_VC = 65536;
constexpr unsigned SL_LKR = SL_QTT, SL_MKR = SL_BCT, SL_MBR = SL_KCT;
constexpr unsigned SL_LW = 49152, SL_LA = 57344, RAW_OFF = 0, RAW_STRIDE = 656;
constexpr unsigned EX_RN = 73728, EX_GC = EX_RN + 256, EX_BON = EX_GC + 256;
static_assert(RAW_OFF + 66 * RAW_STRIDE <= SL_LW && SL_VC + 8192 <= EX_RN && EX_BON + 1024 + 16 <= GRP_BYTES && 2 * GRP_BYTES <= LDS_BYTES - 16, "rwkv LDS map");
constexpr int NGCHUNK = M_TOK / 64;

__device__ __forceinline__ void neumann32(const LdsA& A, int blk, int lane, f32x16& T, f32x16& TT) {
    const int r0 = 32 * blk, hh = lane >> 5, col = lane & 31;
    f32x16 X, XT;
#pragma unroll
    for (int i = 0; i < 16; ++i) { X[i] = 0.f; XT[i] = 0.f; }
#pragma unroll
    for (int kk = 0; kk < 4; ++kk) {
        const bf16x8 fq = ld_frag32(A, SL_QTT, r0, 16 * kk), fb = ld_frag32(A, SL_BCT, r0, 16 * kk);
        X = MFMA32(fq, fb, X); XT = MFMA32(fb, fq, XT);
    }
#pragma unroll
    for (int reg = 0; reg < 16; ++reg) {
        const int row = crow32(reg, hh);
        X[reg] = (col < row) ? X[reg] : 0.f; XT[reg] = (row < col) ? XT[reg] : 0.f;
        const float id = (row == col) ? 1.f : 0.f;
        T[reg] = id - X[reg]; TT[reg] = id - XT[reg];
    }
#pragma unroll
    for (int rnd = 0; rnd < 4; ++rnd) {
        f32x16 X2, XT2;
#pragma unroll
        for (int i = 0; i < 16; ++i) { X2[i] = 0.f; XT2[i] = 0.f; }
#pragma unroll
        for (int s = 0; s < 2; ++s) { const bf16x8 px = pack32(X, s), pxt = pack32(XT, s); X2 = MFMA32(pxt, px, X2); XT2 = MFMA32(px, pxt, XT2); }
        X = X2; XT = XT2;
        { const bf16x8 pxt0 = pack32(XT, 0), pxt1 = pack32(XT, 1), pt0 = pack32(T, 0), pt1 = pack32(T, 1);
          T = MFMA32(pxt0, pt0, T); T = MFMA32(pxt1, pt1, T); TT = MFMA32(pt0, pxt0, TT); TT = MFMA32(pt1, pxt1, TT); }
    }
}
__device__ __forceinline__ f32x16 score_t(const LdsA& A, unsigned slotY, unsigned slotX, int J, int I, bool strict, int lane) {
    f32x16 acc;
#pragma unroll
    for (int i = 0; i < 16; ++i) acc[i] = 0.f;
#pragma unroll
    for (int kk = 0; kk < 4; ++kk) acc = MFMA32(ld_frag32(A, slotY, 32 * J, 16 * kk), ld_frag32(A, slotX, 32 * I, 16 * kk), acc);
    if (J == I) {
        const int hh = lane >> 5, icol = lane & 31;
#pragma unroll
        for (int reg = 0; reg < 16; ++reg) { const int jrow = crow32(reg, hh); const bool keep = strict ? (jrow < icol) : (jrow <= icol); acc[reg] = keep ? acc[reg] : 0.f; }
    }
    return acc;
}

__device__ __forceinline__ void lora_prep_phase(const Params& p) {
    const bf16* Z = (const bf16*)(p.ws + WS_Z); bf16* LD = (bf16*)(p.ws + WS_LD);
    const int gtid = (int)blockIdx.x * NTHREADS + (int)threadIdx.x, NT = (int)gridDim.x * NTHREADS;
    const int c16 = gtid & 15;
    const f32x4 mu0 = *(const f32x4*)(p.shift_mu + C_WDN + c16 * 8), mu1 = *(const f32x4*)(p.shift_mu + C_WDN + c16 * 8 + 4);
    const float mu[8] = {mu0.x, mu0.y, mu0.z, mu0.w, mu1.x, mu1.y, mu1.z, mu1.w};
    constexpr int LB = 6;
    for (int idx0 = gtid; idx0 < M_TOK * 16; idx0 += LB * NT) {
        u32x4 u0[LB], um[LB], up[LB]; bool vm_[LB], vp_[LB];
#pragma unroll
        for (int r = 0; r < LB; ++r) { const int idx = idx0 + r * NT, m = (idx < M_TOK * 16 ? idx : gtid) >> 4; int tp, T; seq_of_token(m, tp, T);
            const bf16* zp = ZS(Z, m, C_WDN + c16 * 8); vm_[r] = tp > 0; vp_[r] = tp < T - 1;
            u0[r] = *(const u32x4*)zp; um[r] = *(const u32x4*)(zp - (vm_[r] ? 64 : 0)); up[r] = *(const u32x4*)(zp + (vp_[r] ? 64 : 0)); }
#pragma unroll
        for (int r = 0; r < LB; ++r) { const int idx = idx0 + r * NT;
            const u32x4 z4 = {0u, 0u, 0u, 0u}; const u32x4 a = u0[r], bm = vm_[r] ? um[r] : z4, bp = vp_[r] ? up[r] : z4;
            const float a0_[8] = {bflo(a.x), bfhi(a.x), bflo(a.y), bfhi(a.y), bflo(a.z), bfhi(a.z), bflo(a.w), bfhi(a.w)};
            const float am[8] = {bflo(bm.x), bfhi(bm.x), bflo(bm.y), bfhi(bm.y), bflo(bm.z), bfhi(bm.z), bflo(bm.w), bfhi(bm.w)};
            const float ap[8] = {bflo(bp.x), bfhi(bp.x), bflo(bp.y), bfhi(bp.y), bflo(bp.z), bfhi(bp.z), bflo(bp.w), bfhi(bp.w)};
            float val[8];
#pragma unroll
            for (int e = 0; e < 8; ++e) val[e] = a0_[e] + mu[e] * (0.5f * (am[e] + ap[e]) - a0_[e]);
            if (c16 < 8) {
#pragma unroll
                for (int e = 0; e < 8; ++e) val[e] = 1.0f - 2.0f * __builtin_amdgcn_rcpf(1.0f + __builtin_amdgcn_exp2f(2.8853900817779268f * val[e]));
            }
            u32x4 o; o.x = cvt2(val[0], val[1]); o.y = cvt2(val[2], val[3]); o.z = cvt2(val[4], val[5]); o.w = cvt2(val[6], val[7]);
            if (idx < M_TOK * 16) *(u32x4*)(LD + (size_t)(idx >> 4) * 128 + c16 * 8) = o; }
    }
    float* RN = (float*)(p.ws + WS_RN);
    const int ch = gtid & 7, h = (gtid >> 3) & 7;
    const f32x4 m0_ = *(const f32x4*)(p.shift_mu + C_K + h * 64 + ch * 8), m1_ = *(const f32x4*)(p.shift_mu + C_K + h * 64 + ch * 8 + 4);
    const f32x4 k0 = *(const f32x4*)(p.k_k + h * 64 + ch * 8), k1 = *(const f32x4*)(p.k_k + h * 64 + ch * 8 + 4);
    const float muk[8] = {m0_.x, m0_.y, m0_.z, m0_.w, m1_.x, m1_.y, m1_.z, m1_.w}, kkv[8] = {k0.x, k0.y, k0.z, k0.w, k1.x, k1.y, k1.z, k1.w};
    const int mstep = NT >> 6;
    for (int mb = gtid >> 6; mb < M_TOK; mb += 8 * mstep) {
        u32x4 u0[8], um[8], up[8];
#pragma unroll
        for (int r = 0; r < 8; ++r) { const int m_ = mb + r * mstep, m = m_ < M_TOK ? m_ : mb; int tp, T; seq_of_token(m, tp, T);
            const bf16* zp = ZS(Z, m, C_K + h * 64 + ch * 8); const bool vm_ = tp > 0, vp_ = tp < T - 1; const u32x4 z4 = {0u, 0u, 0u, 0u};
            u0[r] = *(const u32x4*)zp; const u32x4 xm = *(const u32x4*)(zp - (vm_ ? 64 : 0)), xp = *(const u32x4*)(zp + (vp_ ? 64 : 0));
            um[r] = vm_ ? xm : z4; up[r] = vp_ ? xp : z4; }
#pragma unroll
        for (int r = 0; r < 8; ++r) { const int m = mb + r * mstep;
            const float a0_[8] = {bflo(u0[r].x), bfhi(u0[r].x), bflo(u0[r].y), bfhi(u0[r].y), bflo(u0[r].z), bfhi(u0[r].z), bflo(u0[r].w), bfhi(u0[r].w)};
            const float am[8] = {bflo(um[r].x), bfhi(um[r].x), bflo(um[r].y), bfhi(um[r].y), bflo(um[r].z), bfhi(um[r].z), bflo(um[r].w), bfhi(um[r].w)};
            const float ap[8] = {bflo(up[r].x), bfhi(up[r].x), bflo(up[r].y), bfhi(up[r].y), bflo(up[r].z), bfhi(up[r].z), bflo(up[r].w), bfhi(up[r].w)};
            float ss = 0.f;
#pragma unroll
            for (int e = 0; e < 8; ++e) { const float v_ = a0_[e] + muk[e] * (0.5f * (am[e] + ap[e]) - a0_[e]); const float q = v_ * kkv[e]; ss += q * q; }
            ss = dpp_sum8(ss);
            if (ch == 0 && m < M_TOK) RN[(size_t)m * NH + h] = __builtin_amdgcn_rsqf(fmaxf(ss, 1e-24f)); }
    }
}
#define LDS_BAR() do { asm volatile("s_waitcnt lgkmcnt(0)" ::: "memory"); \
        if (lane_in == 0) __hip_atomic_fetch_add(grp_cnt, 1u, __ATOMIC_RELAXED, __HIP_MEMORY_SCOPE_WORKGROUP); \
        grp_epoch += 4u; \
        while ((unsigned)__builtin_amdgcn_readfirstlane(__hip_atomic_load(grp_cnt, __ATOMIC_RELAXED, __HIP_MEMORY_SCOPE_WORKGROUP)) < grp_epoch) __builtin_amdgcn_s_sleep(1); \
        asm volatile("s_waitcnt lgkmcnt(0)" ::: "memory"); } while (0)
__device__ __forceinline__ void rwkv_pre_phase(const Params& p, LAS unsigned char* lds_wg, int wave, int lane_in) {
    const int grp = wave >> 2, w = wave & 3, z = grp;
    LAS unsigned char* lds = lds_wg + grp * GRP_BYTES;
    const int gt = threadIdx.x & 255;
    LdsA A = make_ldsa((unsigned)(size_t)lds, w, lane_in);
    const bf16* Z = (const bf16*)(p.ws + WS_Z);
    const bf16* wupT = (const bf16*)(p.ws + WS_WUPT); const bf16* aupT = (const bf16*)(p.ws + WS_AUPT);
    LAS float* ex_rn = (LAS float*)(lds + EX_RN); LAS float* ex_gc = (LAS float*)(lds + EX_GC); LAS float* ex_bon = (LAS float*)(lds + EX_BON);
    LAS unsigned* grp_cnt = (LAS unsigned*)(lds + EX_BON + 1024); unsigned grp_epoch = 0u;
    if (gt == 0) *grp_cnt = 0u;
    __syncthreads();
    LAS float* ctab = (LAS float*)(lds_wg + 2 * GRP_BYTES + grp * 4080); int ctab_h = -1;
    const bf16* LD = (const bf16*)(p.ws + WS_LD); const float* RNp = (const float*)(p.ws + WS_RN);
    u32x4 pf[11];
    const int pre_rg = gt / 24, pre_chunk = gt - pre_rg * 24, pre_sg = pre_chunk >> 3, pre_ch = pre_chunk & 7; const bool pre_act = gt < 240;
#define PRE_ISSUE(item_, valid_) do { const int h_ = (item_) & 7, m0_ = ((item_) >> 3) * 64; int tp0_, T_; seq_of_token(m0_, tp0_, T_); \
        const bf16* src_ = ZS(Z, m0_ - 1 + pre_rg, pre_sg * 512 + h_ * 64 + pre_ch * 8); \
        _Pragma("unroll") for (int it = 0; it < 7; ++it) { \
            const int rr_ = 10 * it + pre_rg, tp = tp0_ - 1 + rr_; \
            pf[it] = (u32x4){0u, 0u, 0u, 0u}; \
            if ((valid_) && pre_act && rr_ < 66 && tp >= 0 && tp < T_) pf[it] = *(const u32x4*)(src_ + (size_t)(10 * it) * 64); \
            if ((valid_) && !pre_act && it < 4) { const int jr_ = (gt - 240) * 4 + it; pf[it].x = __float_as_uint(RNp[(size_t)(m0_ + (z ? 63 - jr_ : jr_)) * NH + h_]); } } \
        _Pragma("unroll") for (int q_ = 0; q_ < 4; ++q_) { \
            const int task_ = q_ * 256 + gt, j_ = task_ >> 4, tl_ = z ? 63 - j_ : j_; \
            pf[7 + q_] = (u32x4){0u, 0u, 0u, 0u}; \
            if (valid_) pf[7 + q_] = *(const u32x4*)(LD + (size_t)(m0_ + tl_) * 128 + (task_ & 15) * 8); } } while (0)
    const int nitems = (NGCHUNK * NH - (int)blockIdx.x + (int)gridDim.x - 1) / (int)gridDim.x;
    PRE_ISSUE((int)blockIdx.x, nitems > 0);
    for (int it_ = 0; it_ < nitems; ++it_) {
        const int item = (int)blockIdx.x + it_ * (int)gridDim.x;
        asm volatile("" : "+v"(A.v32), "+v"(A.vp), "+v"(A.v16), "+v"(A.vc), "+v"(A.vt));
        int lane_o = lane_in; asm volatile("" : "+v"(lane_o));
        const int lane = lane_o, cl_ = lane & 15, tq = lane >> 4, hh = lane >> 5;
        const int h = item & 7, gchunk = item >> 3;
        const int m0 = gchunk * 64;
        int tpos0, T; seq_of_token(m0, tpos0, T);
        if (h != ctab_h) {
            ctab[gt] = gt < 128 ? p.shift_mu[C_WDN + gt] : (gt < 192 ? p.shift_mu[C_K + h * 64 + gt - 128] : p.k_k[h * 64 + gt - 192]);
            ctab[256 + gt] = gt < 64 ? p.shift_mu[C_R + h * 64 + gt] : (gt < 128 ? p.shift_mu[C_V + h * 64 + gt - 64] : -1.4426950408889634f * (gt < 192 ? p.w0[z * DRW + h * 64 + gt - 128] : p.a0[z * DRW + h * 64 + gt - 192]));
            if (gt < 128) ctab[512 + gt] = gt < 64 ? p.k_a[h * 64 + gt] : p.r_k[h * 64 + gt - 64];
            ctab_h = h;
        }
        const int c = 16 * w + cl_, hc = h * 64 + c;
        bf16x8 bw[2], ba[2];
#pragma unroll
        for (int s = 0; s < 2; ++s) {
            bw[s] = *(const bf16x8*)(wupT + ((size_t)(z * DRW + hc) * 64 + 32 * s + 8 * tq));
            ba[s] = *(const bf16x8*)(aupT + ((size_t)(z * DRW + hc) * 64 + 32 * s + 8 * tq));
        }
        {
        {
            if (pre_act) {
                LAS unsigned char* dst_ = lds + RAW_OFF + pre_rg * RAW_STRIDE + pre_chunk * 16;
#pragma unroll
                for (int it = 0; it < 7; ++it) if (10 * it + pre_rg < 66) *(LAS u32x4*)(dst_ + it * (10 * RAW_STRIDE)) = pf[it];
            }
            if (!pre_act) {
#pragma unroll
                for (int it = 0; it < 4; ++it) ex_rn[(gt - 240) * 4 + it] = __uint_as_float(pf[it].x);
            }
#pragma unroll
            for (int q_ = 0; q_ < 4; ++q_) { const int task_ = q_ * 256 + gt, j_ = task_ >> 4, c16_ = task_ & 15;
                *(LAS u32x4*)(lds + sw_addr((c16_ >> 3) ? SL_LA : SL_LW, j_, (c16_ & 7) * 16)) = pf[7 + q_]; }
        }
        LDS_BAR();
        f32x4 accw[4], acca[4];
        {
            const float w0s = ctab[384 + c], a0s = ctab[448 + c];
#pragma unroll
            for (int tt = 0; tt < 4; ++tt) {
                accw[tt] = (f32x4){w0s, w0s, w0s, w0s}; acca[tt] = (f32x4){a0s, a0s, a0s, a0s};
#pragma unroll
                for (int s = 0; s < 2; ++s) {
                    accw[tt] = MFMA16(ld_frag16(A, SL_LW, 16 * tt, 32 * s), bw[s], accw[tt]);
                    acca[tt] = MFMA16(ld_frag16(A, SL_LA, 16 * tt, 32 * s), ba[s], acca[tt]);
                }
            }
        }
        float er[4][4], ek[4][4];
        {
            const float mur = ctab[256 + c], muk = ctab[128 + c], muv = ctab[320 + c];
#pragma unroll
            for (int tt = 0; tt < 4; ++tt) {
                const int jb = 16 * tt + 4 * tq, tl0 = z ? 60 - jb : jb;
                const LAS unsigned short* rw_ = (const LAS unsigned short*)(lds + RAW_OFF + tl0 * RAW_STRIDE) + c;
                float ur[6], uk[6], uv[6];
#pragma unroll
                for (int a_ = 0; a_ < 6; ++a_) { ur[a_] = bf2f(rw_[a_ * (RAW_STRIDE / 2)]); uk[a_] = bf2f(rw_[a_ * (RAW_STRIDE / 2) + 64]); uv[a_] = bf2f(rw_[a_ * (RAW_STRIDE / 2) + 128]); }
                float ev[4];
#pragma unroll
                for (int a_ = 0; a_ < 4; ++a_) {
                    const int r_ = z ? 3 - a_ : a_;
                    er[tt][r_] = ur[a_ + 1] + mur * (0.5f * (ur[a_] + ur[a_ + 2]) - ur[a_ + 1]);
                    ek[tt][r_] = uk[a_ + 1] + muk * (0.5f * (uk[a_] + uk[a_ + 2]) - uk[a_ + 1]);
                    ev[r_] = uv[a_ + 1] + muv * (0.5f * (uv[a_] + uv[a_ + 2]) - uv[a_ + 1]);
                }
                { u32x2 v_; v_.x = cvt2(ev[0], ev[1]); v_.y = cvt2(ev[2], ev[3]); *(LAS u32x2*)ldsptr((A.vc ^ (unsigned)(32 * tt)) + SL_VC) = v_; }
            }
        }
        LDS_BAR();
        const float kkc = ctab[192 + c], kac = ctab[512 + c], rkc = ctab[576 + c];
        f32x4 lw[4], av[4];
#pragma unroll
        for (int tt = 0; tt < 4; ++tt)
#pragma unroll
            for (int r_ = 0; r_ < 4; ++r_) { lw[tt][r_] = -0.87503878f * __builtin_amdgcn_rcpf(1.0f + __builtin_amdgcn_exp2f(accw[tt][r_])); av[tt][r_] = __builtin_amdgcn_rcpf(1.0f + __builtin_amdgcn_exp2f(acca[tt][r_])); }
        f32x4 cl4[4];
        {
            bf16x8 bhi[2], blo[2];
#pragma unroll
            for (int s = 0; s < 2; ++s) {
                float lo_[8]; unsigned hi_u[4];
#pragma unroll
                for (int e = 0; e < 8; e += 2) {
                    const float x0 = lw[2 * s + (e >> 2)][e & 3], x1 = lw[2 * s + (e >> 2)][(e & 3) + 1];
                    const unsigned hw = cvt2(x0, x1); hi_u[e >> 1] = hw;
                    lo_[e] = x0 - bflo(hw); lo_[e + 1] = x1 - bfhi(hw);
                }
                bhi[s] = mk8(hi_u[0], hi_u[1], hi_u[2], hi_u[3]);
                blo[s] = mk8(cvt2(lo_[0], lo_[1]), cvt2(lo_[2], lo_[3]), cvt2(lo_[4], lo_[5]), cvt2(lo_[6], lo_[7]));
            }
            const unsigned M0 = ((4 * tq + 0 <= cl_) ? 0x3F80u : 0u) | ((4 * tq + 1 <= cl_) ? 0x3F800000u : 0u), M1 = ((4 * tq + 2 <= cl_) ? 0x3F80u : 0u) | ((4 * tq + 3 <= cl_) ? 0x3F800000u : 0u);
            const unsigned ON = 0x3F803F80u;
            const bf16x8 TA = mk8(M0, M1, 0u, 0u), TB = mk8(ON, ON, M0, M1), T1 = mk8(ON, ON, ON, ON);
            const f32x4 z4 = {0.f, 0.f, 0.f, 0.f};
            cl4[0] = MFMA16(TA, bhi[0], z4); cl4[0] = MFMA16(TA, blo[0], cl4[0]);
            cl4[1] = MFMA16(TB, bhi[0], z4); cl4[1] = MFMA16(TB, blo[0], cl4[1]);
            cl4[2] = MFMA16(T1, bhi[0], z4); cl4[2] = MFMA16(T1, blo[0], cl4[2]); cl4[2] = MFMA16(TA, bhi[1], cl4[2]); cl4[2] = MFMA16(TA, blo[1], cl4[2]);
            cl4[3] = MFMA16(T1, bhi[0], z4); cl4[3] = MFMA16(T1, blo[0], cl4[3]); cl4[3] = MFMA16(TB, bhi[1], cl4[3]); cl4[3] = MFMA16(TB, blo[1], cl4[3]);
        }
        float clast;
        { const auto r32_ = __builtin_amdgcn_permlane32_swap(__float_as_uint(cl4[3][3]), __float_as_uint(cl4[3][3]), false, false);
          const auto r16_ = __builtin_amdgcn_permlane16_swap(r32_[1], r32_[1], false, false); clast = __uint_as_float(r16_[1]); }
        const float gC_ = __builtin_amdgcn_exp2f(clast);
#pragma unroll
        for (int tt = 0; tt < 4; ++tt) {
            float qt[4], rt[4], bc[4], kc[4], kh[4], bh[4], bon[4];
            float g_prev = __builtin_amdgcn_exp2f(cl4[tt][0] - lw[tt][0]);
#pragma unroll
            for (int r_ = 0; r_ < 4; ++r_) {
                const float clv = cl4[tt][r_], a_ = av[tt][r_];
                const float g_in = __builtin_amdgcn_exp2f(clv), g_ex = g_prev, g_inv = __builtin_amdgcn_exp2f(-clv), g_end = gC_ * g_inv;
                g_prev = g_in;
                const float k_ = ek[tt][r_];
                const float kk_ = k_ * kkc * ex_rn[16 * tt + 4 * tq + r_], kd_ = k_ * (1.0f + (a_ - 1.0f) * kac), kka_ = kk_ * a_;
                qt[r_] = kk_ * g_ex; rt[r_] = er[tt][r_] * g_in; bc[r_] = kka_ * g_inv; kc[r_] = kd_ * g_inv; kh[r_] = kd_ * g_end; bh[r_] = kka_ * g_end;
                bon[r_] = er[tt][r_] * rkc * kd_;
            }
#define CMW(slot, lo, hi) do { u32x2 v_; v_.x = (lo); v_.y = (hi); *(LAS u32x2*)ldsptr((A.vc ^ (unsigned)(32 * tt)) + (slot)) = v_; } while (0)
#define TMW(slot, lo, hi) do { const unsigned a_ = (lo), b_ = (hi); \
                *(LAS unsigned short*)ldsptr(A.vt + (slot) + 2048 * tt + 0) = (unsigned short)(a_ & 0xffffu); *(LAS unsigned short*)ldsptr(A.vt + (slot) + 2048 * tt + 128) = (unsigned short)(a_ >> 16); \
                *(LAS unsigned short*)ldsptr((A.vt ^ 16u) + (slot) + 2048 * tt + 256) = (unsigned short)(b_ & 0xffffu); *(LAS unsigned short*)ldsptr((A.vt ^ 16u) + (slot) + 2048 * tt + 384) = (unsigned short)(b_ >> 16); } while (0)
            { const unsigned q0 = cvt2(qt[0], qt[1]), q1 = cvt2(qt[2], qt[3]); CMW(SL_QTC, q0, q1); TMW(SL_QTT, q0, q1); }
            CMW(SL_BHC, cvt2(bh[0], bh[1]), cvt2(bh[2], bh[3]));
            CMW(SL_KHC, cvt2(kh[0], kh[1]), cvt2(kh[2], kh[3]));
            TMW(SL_RTT, cvt2(rt[0], rt[1]), cvt2(rt[2], rt[3]));
            TMW(SL_BCT, cvt2(bc[0], bc[1]), cvt2(bc[2], bc[3]));
            TMW(SL_KCT, cvt2(kc[0], kc[1]), cvt2(kc[2], kc[3]));
            { const float s_ = dpp_rs16x4(bon[0], bon[1], bon[2], bon[3], cl_);
              if (cl_ < 4) ex_bon[w * 64 + 16 * tt + 4 * tq + 2 * (cl_ & 1) + (cl_ >> 1)] = s_; }
#undef CMW
#undef TMW
        }
        if (tq == 3) ex_gc[c] = gC_;
        LDS_BAR();
        }
        {
        f32x16 sc0, sc1, sc2, sc3, sc4;
        if (w == 2) {
            sc0 = score_t(A, SL_KCT, SL_QTT, 0, 0, true, lane); sc1 = score_t(A, SL_KCT, SL_QTT, 0, 1, true, lane); sc2 = score_t(A, SL_KCT, SL_QTT, 1, 1, true, lane);
            sc3 = score_t(A, SL_KCT, SL_RTT, 0, 0, false, lane); sc4 = score_t(A, SL_KCT, SL_RTT, 0, 1, false, lane);
        } else if (w == 3) {
            sc0 = score_t(A, SL_BCT, SL_RTT, 0, 0, false, lane); sc1 = score_t(A, SL_BCT, SL_RTT, 0, 1, false, lane); sc2 = score_t(A, SL_BCT, SL_RTT, 1, 1, false, lane);
            sc3 = score_t(A, SL_KCT, SL_RTT, 1, 1, false, lane);
        } else {
            neumann32(A, w, lane, sc0, sc1);
            if (w == 0) {
                f32x16 l21t;
#pragma unroll
                for (int i = 0; i < 16; ++i) { l21t[i] = 0.f; sc2[i] = 0.f; }
#pragma unroll
                for (int kk = 0; kk < 4; ++kk) l21t = MFMA32(ld_frag32(A, SL_BCT, 0, 16 * kk), ld_frag32(A, SL_QTT, 32, 16 * kk), l21t);
#pragma unroll
                for (int s = 0; s < 2; ++s) sc2 = MFMA32(pack32(l21t, s), pack32(sc0, s), sc2);
            }
        }
        LDS_BAR();
        if (w == 2) {
            write_c(A, SL_LKR, sc0, 0, 0); write_c(A, SL_LKR, sc1, 0, 32); write_c(A, SL_LKR, sc2, 32, 32);
            write_c(A, SL_MKR, sc3, 0, 0); write_c(A, SL_MKR, sc4, 0, 32);
        } else if (w == 3) {
            write_c(A, SL_MBR, sc0, 0, 0); write_c(A, SL_MBR, sc1, 0, 32); write_c(A, SL_MBR, sc2, 32, 32);
            write_c(A, SL_MKR, sc3, 32, 32);
        } else {
            write_c(A, SL_TR, sc1, 32 * w, 32 * w);
        }
        LDS_BAR();
        if (w == 0) {
            f32x16 t21t;
#pragma unroll
            for (int i = 0; i < 16; ++i) t21t[i] = 0.f;
#pragma unroll
            for (int s = 0; s < 2; ++s) t21t = MFMA32(pack32(sc2, s), ld_frag32p(A, SL_TR, 32, 32 + 16 * s), t21t);
#pragma unroll
            for (int i = 0; i < 16; ++i) t21t[i] = -t21t[i];
            write_c(A, SL_TR, t21t, 0, 32);
        }
        LDS_BAR();
        PRE_ISSUE(item + (int)gridDim.x, it_ + 1 < nitems);
        const size_t cc = ((size_t)(z * NGCHUNK + gchunk) * NH + h);
        if (w < 2) {
            const int cb = 32 * w;
            bf16* cmP = (bf16*)(p.ws + WS_CM_P) + cc * 4096; bf16* cmRP = (bf16*)(p.ws + WS_CM_RP) + cc * 4096;
            f32x16 W0, W1;
#pragma unroll
            for (int i = 0; i < 16; ++i) { W0[i] = 0.f; W1[i] = 0.f; }
#pragma unroll
            for (int kk = 0; kk < 2; ++kk) W0 = MFMA32(ld_frag32(A, SL_TR, 0, 16 * kk), ld_frag32(A, SL_QTC, cb, 16 * kk), W0);
#pragma unroll
            for (int kk = 0; kk < 4; ++kk) W1 = MFMA32(ld_frag32(A, SL_TR, 32, 16 * kk), ld_frag32(A, SL_QTC, cb, 16 * kk), W1);
            const bf16x8 pw00 = pack32(W0, 0), pw01 = pack32(W0, 1), pw10 = pack32(W1, 0), pw11 = pack32(W1, 1);
#pragma unroll
            for (int Cp = 0; Cp < 2; ++Cp) {
                f32x16 acc;
#pragma unroll
                for (int i = 0; i < 16; ++i) acc[i] = 0.f;
                acc = MFMA32(pw00, ld_frag32p(A, SL_BHC, 32 * Cp, 0), acc); acc = MFMA32(pw01, ld_frag32p(A, SL_BHC, 32 * Cp, 16), acc);
                acc = MFMA32(pw10, ld_frag32p(A, SL_BHC, 32 * Cp, 32), acc); acc = MFMA32(pw11, ld_frag32p(A, SL_BHC, 32 * Cp, 48), acc);
                const int cp = 32 * Cp + (lane & 31);
                if (Cp == w) {
                    const float gcv = ex_gc[cp];
#pragma unroll
                    for (int g = 0; g < 4; ++g) {
                        const int c0 = cb + 8 * g + 4 * hh;
                        float o_[4];
#pragma unroll
                        for (int rr = 0; rr < 4; ++rr) o_[rr] = ((c0 + rr == cp) ? gcv : 0.f) - acc[4 * g + rr];
                        u32x2 v_; v_.x = cvt2(o_[0], o_[1]); v_.y = cvt2(o_[2], o_[3]);
                        *(u32x2*)(cmP + ((c0 >> 2) * 64 + cp) * 4) = v_;
                    }
                } else {
#pragma unroll
                    for (int g = 0; g < 4; ++g) {
                        const int c0 = cb + 8 * g + 4 * hh;
                        u32x2 v_; v_.x = cvt2(-acc[4 * g], -acc[4 * g + 1]); v_.y = cvt2(-acc[4 * g + 2], -acc[4 * g + 3]);
                        *(u32x2*)(cmP + ((c0 >> 2) * 64 + cp) * 4) = v_;
                    }
                }
            }
#pragma unroll
            for (int Ip = 0; Ip < 2; ++Ip) {
                f32x16 acc;
#pragma unroll
                for (int i = 0; i < 16; ++i) acc[i] = 0.f;
                acc = MFMA32(pw00, ld_frag32p(A, SL_MBR, 32 * Ip, 0), acc); acc = MFMA32(pw01, ld_frag32p(A, SL_MBR, 32 * Ip, 16), acc);
                if (Ip == 1) { acc = MFMA32(pw10, ld_frag32p(A, SL_MBR, 32, 32), acc); acc = MFMA32(pw11, ld_frag32p(A, SL_MBR, 32, 48), acc); }
                const int i_ = 32 * Ip + (lane & 31), tl = z ? 63 - i_ : i_;
#pragma unroll
                for (int g = 0; g < 4; ++g) {
                    const int c0 = cb + 8 * g + 4 * hh;
                    const u32x2 rtv = *(const LAS u32x2*)ldsptr((A.vp ^ (unsigned)((cb / 8 + g) << 4)) + SL_RTT + 32 * Ip * 128);
                    u32x2 v_; v_.x = cvt2(bflo(rtv.x) - acc[4 * g], bfhi(rtv.x) - acc[4 * g + 1]); v_.y = cvt2(bflo(rtv.y) - acc[4 * g + 2], bfhi(rtv.y) - acc[4 * g + 3]);
                    *(u32x2*)(cmRP + ((c0 >> 2) * 64 + tl) * 4) = v_;
                }
            }
        } else {
            const int db = 32 * (w - 2);
            bf16* cmG = (bf16*)(p.ws + WS_CM_G) + cc * 4096; bf16* y0b = (bf16*)p.out + cc * 4096;
            f32x16 X0, X1, U0, U1;
#pragma unroll
            for (int i = 0; i < 16; ++i) { X0[i] = 0.f; X1[i] = 0.f; U0[i] = 0.f; U1[i] = 0.f; }
#pragma unroll
            for (int kk = 0; kk < 2; ++kk) X0 = MFMA32(ld_frag32(A, SL_LKR, 0, 16 * kk), ld_frag32(A, SL_VC, db, 16 * kk), X0);
#pragma unroll
            for (int kk = 0; kk < 4; ++kk) X1 = MFMA32(ld_frag32(A, SL_LKR, 32, 16 * kk), ld_frag32(A, SL_VC, db, 16 * kk), X1);
            { const bf16x8 px00 = pack32(X0, 0), px01 = pack32(X0, 1), px10 = pack32(X1, 0), px11 = pack32(X1, 1);
              U0 = MFMA32(ld_frag32p(A, SL_TR, 0, 0), px00, U0); U0 = MFMA32(ld_frag32p(A, SL_TR, 0, 16), px01, U0);
              U1 = MFMA32(ld_frag32p(A, SL_TR, 32, 0), px00, U1); U1 = MFMA32(ld_frag32p(A, SL_TR, 32, 16), px01, U1);
              U1 = MFMA32(ld_frag32p(A, SL_TR, 32, 32), px10, U1); U1 = MFMA32(ld_frag32p(A, SL_TR, 32, 48), px11, U1); }
            const bf16x8 nu00 = neg8(pack32(U0, 0)), nu01 = neg8(pack32(U0, 1)), nu10 = neg8(pack32(U1, 0)), nu11 = neg8(pack32(U1, 1));
            const int d_ = db + (lane & 31);
#pragma unroll
            for (int Cp = 0; Cp < 2; ++Cp) {
                f32x16 acc;
#pragma unroll
                for (int i = 0; i < 16; ++i) acc[i] = 0.f;
#pragma unroll
                for (int kk = 0; kk < 4; ++kk) acc = MFMA32(ld_frag32(A, SL_KHC, 32 * Cp, 16 * kk), ld_frag32(A, SL_VC, db, 16 * kk), acc);
                acc = MFMA32(ld_frag32p(A, SL_BHC, 32 * Cp, 0), nu00, acc); acc = MFMA32(ld_frag32p(A, SL_BHC, 32 * Cp, 16), nu01, acc);
                acc = MFMA32(ld_frag32p(A, SL_BHC, 32 * Cp, 32), nu10, acc); acc = MFMA32(ld_frag32p(A, SL_BHC, 32 * Cp, 48), nu11, acc);
#pragma unroll
                for (int g = 0; g < 4; ++g) { u32x2 v_; v_.x = cvt2(acc[4 * g], acc[4 * g + 1]); v_.y = cvt2(acc[4 * g + 2], acc[4 * g + 3]);
                    *(u32x2*)(cmG + (unsigned)(((8 * Cp + hh) * 64 + d_) * 4) + g * 512) = v_; }
            }
#pragma unroll
            for (int Ip = 0; Ip < 2; ++Ip) {
                f32x16 acc;
#pragma unroll
                for (int i = 0; i < 16; ++i) acc[i] = 0.f;
#pragma unroll
                for (int kk = 0; kk < 2; ++kk) acc = MFMA32(ld_frag32(A, SL_VC, db, 16 * kk), ld_frag32(A, SL_MKR, 32 * Ip, 16 * kk), acc);
                if (Ip == 1) {
#pragma unroll
                    for (int kk = 2; kk < 4; ++kk) acc = MFMA32(ld_frag32(A, SL_VC, db, 16 * kk), ld_frag32(A, SL_MKR, 32, 16 * kk), acc);
                }
                acc = MFMA32(nu00, ld_frag32p(A, SL_MBR, 32 * Ip, 0), acc); acc = MFMA32(nu01, ld_frag32p(A, SL_MBR, 32 * Ip, 16), acc);
                if (Ip == 1) { acc = MFMA32(nu10, ld_frag32p(A, SL_MBR, 32, 32), acc); acc = MFMA32(nu11, ld_frag32p(A, SL_MBR, 32, 48), acc); }
                const int i_ = 32 * Ip + (lane & 31), tl = z ? 63 - i_ : i_;
#pragma unroll
                for (int g = 0; g < 4; ++g) { u32x2 v_; v_.x = cvt2(acc[4 * g], acc[4 * g + 1]); v_.y = cvt2(acc[4 * g + 2], acc[4 * g + 3]);
                    *(u32x2*)(y0b + (unsigned)((((db >> 2) + hh) * 64 + tl) * 4) + g * 512) = v_; }
            }
            if (w == 2) {
                int j = lane; asm volatile("" : "+v"(j));
                const int tl = z ? 63 - j : j;
                float* bonus = (float*)(p.ws + WS_BONUS);
                bonus[((size_t)(z * NGCHUNK + gchunk) * NH + h) * 64 + tl] = (ex_bon[j] + ex_bon[64 + j]) + (ex_bon[128 + j] + ex_bon[192 + j]);
            }
        }
        LDS_BAR();
        }
    }
    __syncthreads();
}

#undef PRE_ISSUE
#undef LDS_BAR
constexpr size_t HOFF = (size_t)2 * 1536 * 8 * 4096;
__device__ __forceinline__ void rwkv_scan_chain(const Params& p, int z, int seq, int h, int w, int lane, int nb, int ne, f32x4 (&H)[4]) {
    int start, T; seq_info(seq, start, T);
    const int nchunk = T / 64, g0 = start / 64;
    const int cl_ = lane & 15, q = lane >> 4, d_ = 16 * w + cl_;
    const bf16* cmP = (const bf16*)(p.ws + WS_CM_P); const bf16* cmG = (const bf16*)(p.ws + WS_CM_G);
    bf16* hb_out = (bf16*)p.out + HOFF;
    bf16x8 ap[4][4][2]; u32x2 gv[4][4];
#define SCAN_CC(n_) ((size_t)(z * NGCHUNK + g0 + (z ? nchunk - 1 - (n_) : (n_))) * NH + h)
#define SCAN_LOAD(u_, n_) do { const size_t cc_ = SCAN_CC(n_); const bf16* pp_ = cmP + cc_ * 4096; const bf16* gg_ = cmG + cc_ * 4096; \
        _Pragma("unroll") for (int rt = 0; rt < 4; ++rt) { \
            _Pragma("unroll") for (int s_ = 0; s_ < 2; ++s_) { const u32x2 lo_ = *(const u32x2*)(pp_ + ((8 * s_ + q) * 64 + 16 * rt + cl_) * 4), hi_ = *(const u32x2*)(pp_ + ((8 * s_ + 4 + q) * 64 + 16 * rt + cl_) * 4); \
                ap[u_][rt][s_] = mk8(lo_.x, lo_.y, hi_.x, hi_.y); } \
            gv[u_][rt] = *(const u32x2*)(gg_ + ((4 * rt + q) * 64 + d_) * 4); } } while (0)
    unsigned tchP[8], tchG[8];
#define SCAN_TOUCH(t_, n_) do { const size_t cc_ = SCAN_CC(n_); \
        tchP[t_] = *(const unsigned*)((const char*)(cmP + cc_ * 4096) + lane * 128); \
        tchG[t_] = *(const unsigned*)((const char*)(cmG + cc_ * 4096) + cl_ * 512 + w * 128); } while (0)
#pragma unroll
    for (int u = 0; u < 4; ++u) SCAN_LOAD(u, nb + u);
#pragma unroll
    for (int t = 0; t < 8; ++t) { tchP[t] = 0u; tchG[t] = 0u; if (nb + t + 4 < ne) SCAN_TOUCH(t, nb + t + 4); }
    for (int n0 = nb; n0 < ne; n0 += 8) {
#pragma unroll
        for (int t = 0; t < 8; ++t) {
            const int n = n0 + t, u = t & 3;
            unsigned hw[4][2];
#pragma unroll
            for (int rt = 0; rt < 4; ++rt) { hw[rt][0] = cvt2(H[rt][0], H[rt][1]); hw[rt][1] = cvt2(H[rt][2], H[rt][3]); }
            bf16* ho = hb_out + SCAN_CC(n) * 4096 + (q * 64 + d_) * 4;
#pragma unroll
            for (int rt = 0; rt < 4; ++rt) { u32x2 v_; v_.x = hw[rt][0]; v_.y = hw[rt][1]; *(u32x2*)(ho + rt * 1024) = v_; }
            const bf16x8 hb0 = mk8(hw[0][0], hw[0][1], hw[1][0], hw[1][1]), hb1 = mk8(hw[2][0], hw[2][1], hw[3][0], hw[3][1]);
#pragma unroll
            for (int rt = 0; rt < 4; ++rt) {
                f32x4 acc = {bflo(gv[u][rt].x), bfhi(gv[u][rt].x), bflo(gv[u][rt].y), bfhi(gv[u][rt].y)};
                acc = MFMA16(ap[u][rt][0], hb0, acc); acc = MFMA16(ap[u][rt][1], hb1, acc);
                H[rt] = acc;
            }
            if (n + 4 < ne) SCAN_LOAD(u, n + 4);
            asm volatile("" :: "v"(tchP[t]), "v"(tchG[t]));
            if (n + 12 < ne) SCAN_TOUCH(t, n + 12);
        }
    }
#undef SCAN_LOAD
#undef SCAN_TOUCH
#undef SCAN_CC
}
__device__ __forceinline__ void mix_phase3(const Params& p, LAS unsigned char* lds_wg, int wave, int lane_in, int item_lo, int item_hi, int slot, int nslots) {
    const bf16* Z = (const bf16*)(p.ws + WS_Z);
    bf16* MX = (bf16*)(p.ws + WS_MIXED);
    const float* bonus = (const float*)(p.ws + WS_BONUS);
    const bf16* cmRP = (const bf16*)(p.ws + WS_CM_RP); const bf16* y0b = (const bf16*)p.out; const bf16* hb_in = (const bf16*)p.out + HOFF;
    LAS unsigned char* lds = lds_wg + wave * 16384;
    const unsigned lb = (unsigned)(size_t)lds;
    for (int item = item_lo + slot; item < item_hi; item += nslots) {
        int lane_o = lane_in; asm volatile("" : "+v"(lane_o));
        const int lane = lane_o, l31 = lane & 31, hh = lane >> 5;
        const unsigned vp = lb + l31 * 128 + ((((l31 >> 1) & 7)) << 4) + 8 * hh;
        const int h = item & 7, gchunk = item >> 3, m0 = gchunk * 64;
        int tpos0, T; seq_of_token(m0, tpos0, T);
        const int ch = lane & 7;
        const f32x4 mv0 = *(const f32x4*)(p.shift_mu + C_V + h * 64 + 8 * ch), mv1 = *(const f32x4*)(p.shift_mu + C_V + h * 64 + 8 * ch + 4);
        const f32x4 mg0 = *(const f32x4*)(p.shift_mu + C_G + h * 64 + 8 * ch), mg1 = *(const f32x4*)(p.shift_mu + C_G + h * 64 + 8 * ch + 4);
        const float muv[8] = {mv0.x, mv0.y, mv0.z, mv0.w, mv1.x, mv1.y, mv1.z, mv1.w}, mug[8] = {mg0.x, mg0.y, mg0.z, mg0.w, mg1.x, mg1.y, mg1.z, mg1.w};
#pragma unroll 1
        for (int it0 = 0; it0 < 8; it0 += 4) {
            u32x4 v0[4], g0[4], vm[4], vq[4], gm[4], gq[4]; float bon[4];
#pragma unroll
            for (int r = 0; r < 4; ++r) {
                const int row = (it0 + r) * 8 + (lane >> 3), m = m0 + row, tp = tpos0 + row;
                const bf16* zv = ZS(Z, m, C_V + h * 64 + 8 * ch); const bf16* zg = ZS(Z, m, C_G + h * 64 + 8 * ch);
                const int dm = tp > 0 ? 64 : 0, dq = tp < T - 1 ? 64 : 0;
                v0[r] = *(const u32x4*)zv; g0[r] = *(const u32x4*)zg;
                vm[r] = *(const u32x4*)(zv - dm); gm[r] = *(const u32x4*)(zg - dm);
                vq[r] = *(const u32x4*)(zv + dq); gq[r] = *(const u32x4*)(zg + dq);
                bon[r] = bonus[((size_t)gchunk * NH + h) * 64 + row] + bonus[((size_t)(NGCHUNK + gchunk) * NH + h) * 64 + row];
            }
#pragma unroll
            for (int r = 0; r < 4; ++r) {
                const int row = (it0 + r) * 8 + (lane >> 3), tp = tpos0 + row;
                const u32x4 z4 = {0u, 0u, 0u, 0u};
                const u32x4 a = v0[r], b = g0[r], am_ = tp > 0 ? vm[r] : z4, bm_ = tp > 0 ? gm[r] : z4, aq_ = tp < T - 1 ? vq[r] : z4, bq_ = tp < T - 1 ? gq[r] : z4;
                const float fv0[8] = {bflo(a.x), bfhi(a.x), bflo(a.y), bfhi(a.y), bflo(a.z), bfhi(a.z), bflo(a.w), bfhi(a.w)};
                const float fvm[8] = {bflo(am_.x), bfhi(am_.x), bflo(am_.y), bfhi(am_.y), bflo(am_.z), bfhi(am_.z), bflo(am_.w), bfhi(am_.w)};
                const float fvq[8] = {bflo(aq_.x), bfhi(aq_.x), bflo(aq_.y), bfhi(aq_.y), bflo(aq_.z), bfhi(aq_.z), bflo(aq_.w), bfhi(aq_.w)};
                const float fg0[8] = {bflo(b.x), bfhi(b.x), bflo(b.y), bfhi(b.y), bflo(b.z), bfhi(b.z), bflo(b.w), bfhi(b.w)};
                const float fgm[8] = {bflo(bm_.x), bfhi(bm_.x), bflo(bm_.y), bfhi(bm_.y), bflo(bm_.z), bfhi(bm_.z), bflo(bm_.w), bfhi(bm_.w)};
                const float fgq[8] = {bflo(bq_.x), bfhi(bq_.x), bflo(bq_.y), bfhi(bq_.y), bflo(bq_.z), bfhi(bq_.z), bflo(bq_.w), bfhi(bq_.w)};
                float av_[8], sg_[8];
#pragma unroll
                for (int e = 0; e < 8; ++e) {
                    av_[e] = bon[r] * (fv0[e] + muv[e] * (0.5f * (fvm[e] + fvq[e]) - fv0[e]));
                    const float gt = fg0[e] + mug[e] * (0.5f * (fgm[e] + fgq[e]) - fg0[e]);
                    sg_[e] = gt * fsigmoid(gt);
                }
                u32x4 oa, os; oa.x = cvt2(av_[0], av_[1]); oa.y = cvt2(av_[2], av_[3]); oa.z = cvt2(av_[4], av_[5]); oa.w = cvt2(av_[6], av_[7]);
                os.x = cvt2(sg_[0], sg_[1]); os.y = cvt2(sg_[2], sg_[3]); os.z = cvt2(sg_[4], sg_[5]); os.w = cvt2(sg_[6], sg_[7]);
                *(LAS u32x4*)(lds + sw_addr(0, row, ch * 16)) = oa; *(LAS u32x4*)(lds + sw_addr(8192, row, ch * 16)) = os;
            }
        }
        f32x16 acc[2][2];
        const size_t cc0 = ((size_t)(0 * NGCHUNK + gchunk) * NH + h) * 4096, cc1 = ((size_t)(1 * NGCHUNK + gchunk) * NH + h) * 4096;
#pragma unroll
        for (int D = 0; D < 2; ++D)
#pragma unroll
            for (int I = 0; I < 2; ++I)
#pragma unroll
                for (int g = 0; g < 4; ++g) {
                    const size_t off = (size_t)((8 * D + 2 * g + hh) * 64 + 32 * I + l31) * 4;
                    const u32x2 a = *(const u32x2*)(y0b + cc0 + off), b = *(const u32x2*)(y0b + cc1 + off);
                    acc[D][I][4 * g + 0] = bflo(a.x) + bflo(b.x); acc[D][I][4 * g + 1] = bfhi(a.x) + bfhi(b.x);
                    acc[D][I][4 * g + 2] = bflo(a.y) + bflo(b.y); acc[D][I][4 * g + 3] = bfhi(a.y) + bfhi(b.y);
                }
#pragma unroll
        for (int zz = 0; zz < 2; ++zz) {
            const bf16* hp = hb_in + (zz ? cc1 : cc0); const bf16* rp = cmRP + (zz ? cc1 : cc0);
#pragma unroll
            for (int kk = 0; kk < 4; ++kk) {
                bf16x8 fa[2], fb[2];
#pragma unroll
                for (int t = 0; t < 2; ++t) { const int o_ = ((4 * kk + 2 * hh) * 64 + 32 * t + l31) * 4;
                    const u32x2 a0 = *(const u32x2*)(hp + o_), a1 = *(const u32x2*)(hp + o_ + 256), b0 = *(const u32x2*)(rp + o_), b1 = *(const u32x2*)(rp + o_ + 256);
                    fa[t] = mk8(a0.x, a0.y, a1.x, a1.y); fb[t] = mk8(b0.x, b0.y, b1.x, b1.y); }
#pragma unroll
                for (int D = 0; D < 2; ++D)
#pragma unroll
                    for (int I = 0; I < 2; ++I) acc[D][I] = MFMA32(fa[D], fb[I], acc[D][I]);
            }
        }
#pragma unroll
        for (int I = 0; I < 2; ++I) {
            float s1 = 0.f;
#pragma unroll
            for (int D = 0; D < 2; ++D)
#pragma unroll
                for (int r_ = 0; r_ < 16; ++r_) s1 += acc[D][I][r_];
            s1 = add_xor32(s1);
            const float mean = s1 * (1.0f / 64.0f);
            float s2 = 0.f;
#pragma unroll
            for (int D = 0; D < 2; ++D)
#pragma unroll
                for (int r_ = 0; r_ < 16; ++r_) { const float dlt = acc[D][I][r_] - mean; s2 += dlt * dlt; }
            s2 = add_xor32(s2);
            const float rstd = __builtin_amdgcn_rsqf(s2 * (1.0f / 64.0f) + 64e-5f);
#pragma unroll
            for (int D = 0; D < 2; ++D)
#pragma unroll
                for (int g = 0; g < 4; ++g) {
                    const int d0 = 32 * D + 8 * g + 4 * hh;
                    const f32x4 lg = *(const f32x4*)(p.lnx_g + h * 64 + d0), lbv = *(const f32x4*)(p.lnx_b + h * 64 + d0);
                    const unsigned ad = (vp ^ (unsigned)((4 * D + g) << 4)) + 32 * I * 128;
                    const u32x2 av_ = *(const LAS u32x2*)ldsptr(ad), sg_ = *(const LAS u32x2*)ldsptr(ad + 8192);
                    const float r0 = ((acc[D][I][4 * g + 0] - mean) * rstd * lg.x + lbv.x + bflo(av_.x)) * bflo(sg_.x);
                    const float r1 = ((acc[D][I][4 * g + 1] - mean) * rstd * lg.y + lbv.y + bfhi(av_.x)) * bfhi(sg_.x);
                    const float r2 = ((acc[D][I][4 * g + 2] - mean) * rstd * lg.z + lbv.z + bflo(av_.y)) * bflo(sg_.y);
                    const float r3 = ((acc[D][I][4 * g + 3] - mean) * rstd * lg.w + lbv.w + bfhi(av_.y)) * bfhi(sg_.y);
                    u32x2 o; o.x = cvt2(r0, r1); o.y = cvt2(r2, r3);
                    *(LAS u32x2*)ldsptr(ad) = o;
                }
        }
#pragma unroll 2
        for (int it = 0; it < 8; ++it) {
            const int row = it * 8 + (lane >> 3), ch = lane & 7, m = m0 + row;
            const u32x4 o = *(const LAS u32x4*)(lds + sw_addr(0, row, ch * 16));
            *(u32x4*)(MX + (size_t)m * 512 + h * 64 + 8 * ch) = o;
        }
    }
}

constexpr unsigned NA_K = 0, NA_VT = 9 * 8192, NA_VT_SLOT = 64 * 136, NA_TBL = NA_VT + 9 * NA_VT_SLOT;
static_assert(NA_TBL + 15 * 64 * 4 <= LDS_BYTES - 16, "NA LDS map");
constexpr int NA_PAIRS = 2 * 8 * 128 + 16 * 8 * 32;
struct NaRow { u32x4 k, v; };
__device__ __forceinline__ NaRow na_row_issue(const Params& p, int start, int head, int rho, int tid) {
    const bf16* Z = (const bf16*)(p.ws + WS_Z);
    NaRow r;
    r.k = *(const u32x4*)ZS(Z, start + rho * 64 + (tid >> 3), C_AK + head * 64 + 8 * (tid & 7));
    r.v = *(const u32x4*)ZS(Z, start + rho * 64 + (tid & 63), C_AV + head * 64 + 8 * (tid >> 6));
    return r;
}
__device__ __forceinline__ void na_row_commit(LAS unsigned char* lds, int rho, int tid, const NaRow& r, const f32x4& g0, const f32x4& g1) {
    const int slot = rho % 9;
    {
        const int col = tid >> 3, ch = tid & 7;
        const u32x4 w = r.k;
        float f[8] = {bflo(w.x), bfhi(w.x), bflo(w.y), bfhi(w.y), bflo(w.z), bfhi(w.z), bflo(w.w), bfhi(w.w)};
        float ss = 0.f;
#pragma unroll
        for (int e = 0; e < 8; ++e) ss += f[e] * f[e];
        ss = dpp_sum8(ss);
        const float rstd = __builtin_amdgcn_rsqf(ss * (1.0f / 64.0f) + 1e-6f);
        u32x4 o; o.x = cvt2(f[0] * rstd * g0.x, f[1] * rstd * g0.y); o.y = cvt2(f[2] * rstd * g0.z, f[3] * rstd * g0.w);
        o.z = cvt2(f[4] * rstd * g1.x, f[5] * rstd * g1.y); o.w = cvt2(f[6] * rstd * g1.z, f[7] * rstd * g1.w);
        *(LAS u32x4*)(lds + NA_K + slot * 8192 + col * 128 + ((ch ^ ((col >> 1) & 7)) << 4)) = o;
    }
    {
        const int ch = tid >> 6, col = tid & 63;
        const u32x4 w = r.v;
        LAS unsigned short* vt = (LAS unsigned short*)(lds + NA_VT + slot * NA_VT_SLOT + (8 * ch) * 136 + col * 2);
        vt[0 * 68] = (unsigned short)(w.x & 0xffffu); vt[1 * 68] = (unsigned short)(w.x >> 16); vt[2 * 68] = (unsigned short)(w.y & 0xffffu); vt[3 * 68] = (unsigned short)(w.y >> 16);
        vt[4 * 68] = (unsigned short)(w.z & 0xffffu); vt[5 * 68] = (unsigned short)(w.z >> 16); vt[6 * 68] = (unsigned short)(w.w & 0xffffu); vt[7 * 68] = (unsigned short)(w.w >> 16);
    }
}
__device__ __forceinline__ void na_pair_info(int gp, int& seq, int& head, int& pr, int& R) {
    if (gp < 2048) { const int u = gp >> 7; seq = u >> 3; head = u & 7; pr = gp & 127; R = 256; }
    else { const int g2 = gp - 2048, u = g2 >> 5; seq = 2 + (u >> 3); head = u & 7; pr = g2 & 31; R = 64; }
}
__device__ __forceinline__ void na_phase(const Params& p, LAS unsigned char* lds, int wave, int lane) {
    const bf16* Z = (const bf16*)(p.ws + WS_Z);
    bf16* YAo = (bf16*)(p.ws + WS_YA);
    const int tid = threadIdx.x, cl = lane & 15, q4 = lane >> 4, rw = wave >> 2, qb = wave & 3;
    const int kw0 = (qb == 0) ? 0 : (qb == 1 ? 8 : (qb == 2 ? 24 : 32));
    const int qc = 16 * qb + cl;
    constexpr float LOG2E = 1.4426950408889634f;
    float vf[2][4];
    { int cs = qc - 8; cs = cs < 0 ? 0 : (cs > 48 ? 48 : cs);
#pragma unroll
      for (int ct = 0; ct < 2; ++ct)
#pragma unroll
        for (int reg = 0; reg < 4; ++reg) { const int kc = kw0 + 16 * ct + 4 * q4 + reg; vf[ct][reg] = (kc >= cs && kc < cs + 16) ? 1.f : 0.f; } }
    const unsigned lbase = (unsigned)(size_t)lds;
    const unsigned vK = lbase + NA_K + (kw0 + cl) * 128 + (((q4 ^ (((kw0 >> 1) + (cl >> 1)) & 7)) & 7) << 4);
    const unsigned vV = lbase + NA_VT + cl * 136 + (kw0 + 4 * q4) * 2;
    const unsigned vB = lbase + NA_TBL + (kw0 + 4 * q4 - 16 * qb - cl + 31) * 4;
    float gq[2][8];
#pragma unroll
    for (int s = 0; s < 2; ++s)
#pragma unroll
        for (int e = 0; e < 8; ++e) gq[s][e] = p.q_norm_g[32 * s + 8 * q4 + e] * (0.125f * LOG2E);
    f32x4 kg0 = *(const f32x4*)(p.k_norm_g + 8 * (tid & 7)), kg1 = *(const f32x4*)(p.k_norm_g + 8 * (tid & 7) + 4);
    asm volatile("" : "+v"(kg0), "+v"(kg1));
    int cur_unit = -1, have_hi = -1;
    u32x4 qn[2]; qn[0] = (u32x4){0u, 0u, 0u, 0u}; qn[1] = qn[0];
    const int na_per = (NA_PAIRS + (int)gridDim.x - 1) / (int)gridDim.x;
    if ((int)blockIdx.x * na_per < NA_PAIRS) {
        int s0, h0, pr0, R0; na_pair_info((int)blockIdx.x * na_per, s0, h0, pr0, R0);
        int st0, ln0; seq_info(s0, st0, ln0); const int mq0 = st0 + (2 * pr0 + rw) * 64 + qc;
        qn[0] = *(const u32x4*)ZS(Z, mq0, C_AQ + h0 * 64 + 8 * q4); qn[1] = *(const u32x4*)ZS(Z, mq0, C_AQ + h0 * 64 + 32 + 8 * q4);
    }
    for (int k = 0; k < na_per; ++k) {
        const int gp = blockIdx.x * na_per + k;
        if (gp >= NA_PAIRS) break;
        int seq, head, pr, R; na_pair_info(gp, seq, head, pr, R);
        int start, len; seq_info(seq, start, len);
        const int r = 2 * pr;
        int lo = r - 4; lo = lo < 0 ? 0 : (lo > R - 8 ? R - 8 : lo);
        int hi = r - 3; hi = (hi < 0 ? 0 : (hi > R - 8 ? R - 8 : hi)) + 7;
        const int unit = seq * 8 + head;
        int first = have_hi + 1;
        if (unit != cur_unit) {
            first = lo;
            for (int i = tid; i < 15 * 64; i += NTHREADS) { const int dr = i >> 6, dc = (i & 63) - 16;
                ((LAS float*)(lds + NA_TBL))[i] = (dc >= 0 && dc <= 30) ? p.rpb[(head * 15 + dr) * 31 + dc] * LOG2E : 0.f; }
        }
        {
            NaRow rws[9];
#pragma unroll
            for (int i = 0; i < 9; ++i) { rws[i].k = (u32x4){0u, 0u, 0u, 0u}; rws[i].v = rws[i].k; if (first + i <= hi) rws[i] = na_row_issue(p, start, head, first + i, tid); }
#pragma unroll
            for (int i = 0; i < 9; ++i) if (first + i <= hi) na_row_commit(lds, first + i, tid, rws[i], kg0, kg1);
        }
        cur_unit = unit; have_hi = hi;
        __syncthreads();
        int nrow0 = 0, nrows = 0; NaRow nx0, nx1;
        nx0.k = (u32x4){0u, 0u, 0u, 0u}; nx0.v = nx0.k; nx1 = nx0;
        u32x4 qnx0 = {0u, 0u, 0u, 0u}, qnx1 = {0u, 0u, 0u, 0u}; bool qnx = false;
        if (k + 1 < na_per && gp + 1 < NA_PAIRS) {
            int s2, h2, pr2, R2; na_pair_info(gp + 1, s2, h2, pr2, R2);
            { int st2, ln2; seq_info(s2, st2, ln2); const int mq2 = st2 + (2 * pr2 + rw) * 64 + qc;
              qnx0 = *(const u32x4*)ZS(Z, mq2, C_AQ + h2 * 64 + 8 * q4); qnx1 = *(const u32x4*)ZS(Z, mq2, C_AQ + h2 * 64 + 32 + 8 * q4); qnx = true; }
            if (s2 * 8 + h2 == unit) {
                int hi2 = 2 * pr2 - 3; hi2 = (hi2 < 0 ? 0 : (hi2 > R2 - 8 ? R2 - 8 : hi2)) + 7;
                nrow0 = hi + 1; nrows = hi2 - hi;
                if (nrows > 0) nx0 = na_row_issue(p, start, head, nrow0, tid);
                if (nrows > 1) nx1 = na_row_issue(p, start, head, nrow0 + 1, tid);
            }
        }
        const int rq = r + rw;
        int kr0 = rq - 4; kr0 = kr0 < 0 ? 0 : (kr0 > R - 8 ? R - 8 : kr0);
        const int mq = start + rq * 64 + qc;
        u32x2 gw[4];
#pragma unroll
        for (int dt = 0; dt < 4; ++dt) gw[dt] = *(const u32x2*)ZS(Z, mq, C_AG + head * 64 + 16 * dt + 4 * q4);
        bf16x8 qf[2];
        { float f[2][8]; float ss = 0.f;
          u32x4 qw[2];
          qw[0] = qn[0]; qw[1] = qn[1];
#pragma unroll
          for (int s = 0; s < 2; ++s) { const u32x4 w = qw[s];
              f[s][0] = bflo(w.x); f[s][1] = bfhi(w.x); f[s][2] = bflo(w.y); f[s][3] = bfhi(w.y); f[s][4] = bflo(w.z); f[s][5] = bfhi(w.z); f[s][6] = bflo(w.w); f[s][7] = bfhi(w.w);
#pragma unroll
              for (int e = 0; e < 8; ++e) ss += f[s][e] * f[s][e]; }
          ss = add_xor32(add_xor16(ss));
          const float rstd = __builtin_amdgcn_rsqf(ss * (1.0f / 64.0f) + 1e-6f);
#pragma unroll
          for (int s = 0; s < 2; ++s) qf[s] = mk8(cvt2(f[s][0] * rstd * gq[s][0], f[s][1] * rstd * gq[s][1]), cvt2(f[s][2] * rstd * gq[s][2], f[s][3] * rstd * gq[s][3]),
                                                  cvt2(f[s][4] * rstd * gq[s][4], f[s][5] * rstd * gq[s][5]), cvt2(f[s][6] * rstd * gq[s][6], f[s][7] * rstd * gq[s][7])); }
        f32x4 S[8][2];
        float mx = -1e30f;
        const unsigned vBr = vB + (unsigned)((kr0 - rq + 7) * 256);
        const int slot0 = kr0 % 9;
        {
            bf16x8 kf[2][2][2]; float bb[2][2][4];
#define NA_LDK(buf_, kr_, ks_) do { _Pragma("unroll") for (int ct = 0; ct < 2; ++ct) { \
                _Pragma("unroll") for (int s_ = 0; s_ < 2; ++s_) kf[buf_][ct][s_] = *(const LAS bf16x8*)ldsptr((vK ^ (unsigned)(s_ << 6)) + (ks_) + ct * 2048); \
                _Pragma("unroll") for (int reg = 0; reg < 4; ++reg) bb[buf_][ct][reg] = *(const LAS float*)ldsptr(vBr + (kr_) * 256 + (16 * ct + reg) * 4); } } while (0)
            int slot = slot0;
            NA_LDK(0, 0, (unsigned)(slot * 8192));
#pragma unroll
            for (int kr = 0; kr < 8; ++kr) {
                if (kr < 7) { slot = (slot == 8) ? 0 : slot + 1; NA_LDK((kr + 1) & 1, kr + 1, (unsigned)(slot * 8192)); }
#pragma unroll
                for (int ct = 0; ct < 2; ++ct) {
                    f32x4 acc = {0.f, 0.f, 0.f, 0.f};
#pragma unroll
                    for (int s_ = 0; s_ < 2; ++s_) acc = MFMA16(kf[kr & 1][ct][s_], qf[s_], acc);
#pragma unroll
                    for (int reg = 0; reg < 4; ++reg) { acc[reg] += bb[kr & 1][ct][reg]; mx = fmaxf(mx, acc[reg]); }
                    S[kr][ct] = acc;
                }
            }
#undef NA_LDK
        }
        mx = max_xor32(max_xor16(mx));
        float lsum = 0.f;
        f32x4 O[4];
#pragma unroll
        for (int dt = 0; dt < 4; ++dt) O[dt] = (f32x4){0.f, 0.f, 0.f, 0.f};
        {
            u32x2 vfr[2][4][2];
#define NA_LDV(buf_, vs_) do { _Pragma("unroll") for (int dt = 0; dt < 4; ++dt) { vfr[buf_][dt][0] = *(const LAS u32x2*)ldsptr(vV + (vs_) + dt * 2176); vfr[buf_][dt][1] = *(const LAS u32x2*)ldsptr(vV + (vs_) + dt * 2176 + 32); } } while (0)
            int slot = slot0;
            NA_LDV(0, (unsigned)(slot * NA_VT_SLOT));
#pragma unroll
            for (int kr = 0; kr < 8; ++kr) {
                if (kr < 7) { slot = (slot == 8) ? 0 : slot + 1; NA_LDV((kr + 1) & 1, (unsigned)(slot * NA_VT_SLOT)); }
                float pe[2][4];
#pragma unroll
                for (int ct = 0; ct < 2; ++ct)
#pragma unroll
                    for (int reg = 0; reg < 4; ++reg) { pe[ct][reg] = __builtin_amdgcn_exp2f(S[kr][ct][reg] - mx) * vf[ct][reg]; lsum += pe[ct][reg]; }
                const bf16x8 pa = mk8(cvt2(pe[0][0], pe[0][1]), cvt2(pe[0][2], pe[0][3]), cvt2(pe[1][0], pe[1][1]), cvt2(pe[1][2], pe[1][3]));
#pragma unroll
                for (int dt = 0; dt < 4; ++dt)
                    O[dt] = MFMA16(mk8(vfr[kr & 1][dt][0].x, vfr[kr & 1][dt][0].y, vfr[kr & 1][dt][1].x, vfr[kr & 1][dt][1].y), pa, O[dt]);
            }
#undef NA_LDV
        }
        lsum = add_xor32(add_xor16(lsum));
        const float linv = __builtin_amdgcn_rcpf(lsum);
        {
            bf16* yt = YAo + (size_t)mq * 512 + head * 64 + 4 * q4;
#pragma unroll
            for (int dt = 0; dt < 4; ++dt) {
                const float g0 = bflo(gw[dt].x), g1 = bfhi(gw[dt].x), g2 = bflo(gw[dt].y), g3 = bfhi(gw[dt].y);
                u32x2 v_; v_.x = cvt2(O[dt][0] * linv * (g0 * fsigmoid(g0)), O[dt][1] * linv * (g1 * fsigmoid(g1)));
                v_.y = cvt2(O[dt][2] * linv * (g2 * fsigmoid(g2)), O[dt][3] * linv * (g3 * fsigmoid(g3)));
                *(u32x2*)(yt + 16 * dt) = v_; }
        }
        __syncthreads();
        if (nrows > 0) na_row_commit(lds, nrow0, tid, nx0, kg0, kg1);
        if (nrows > 1) na_row_commit(lds, nrow0 + 1, tid, nx1, kg0, kg1);
        have_hi += nrows;
        qn[0] = qnx0; qn[1] = qnx1;
    }
}

__global__ void __launch_bounds__(NTHREADS, 2) fwd_megakernel(Params p) {
    extern __shared__ __attribute__((aligned(16))) unsigned char lds_raw[];
    LAS unsigned char* lds = (LAS unsigned char*)lds_raw;
    const int tid = threadIdx.x, lane = tid & 63, wave = __builtin_amdgcn_readfirstlane(tid >> 6);
    volatile LAS unsigned* bar_st = (volatile LAS unsigned*)(lds + LDS_BYTES - 16);
    if (tid == 0) { bar_st[0] = 0u; bar_st[1] = 0u; bar_st[2] = 0u; bar_st[3] = 0u; }
    __syncthreads();
    XcdBarrier gbar = xcd_barrier_post((unsigned*)(p.ws + WS_CTL) + 4096, bar_st);
#ifndef NO_P0
    for (int rep = 0; rep < PROBE_REP_P0; ++rep) p0_prologue(p, lds, wave, lane);
#endif
    xcd_barrier(gbar);
#ifndef NO_G1
    { pg8::Gemm g{(const pg8::bf16_t*)p.out, (const pg8::bf16_t*)(p.ws + WS_WINT), M_TOK, DINP, DM, DM, (const pg8::bf16_t*)p.out, DM / 64};
      pg8::StaticOrder S; S.init(M_TOK, DINP, (int)gridDim.x, (int)blockIdx.x, (DINP - DIN == 128) ? 1 : 0);
      pg8::EpiBf16<0> E{(pg8::bf16_t*)(p.ws + WS_Z), 64, nullptr, 0, ZSLAB};
      pg8::gemm_phase<pg8::EpiBf16<0>, pg8::StaticOrder>((PG8_LAS unsigned char*)lds, g, S, E, nullptr); }
#endif
    xcd_barrier(gbar);
    lora_prep_phase(p);
    xcd_barrier(gbar);
#ifndef NO_NA
    for (int rep = 0; rep < PROBE_REP_NA; ++rep) { na_phase(p, lds, wave, lane); __syncthreads(); }
#endif
#ifndef NO_PRE
    for (int rep = 0; rep < PROBE_REP_PRE; ++rep) rwkv_pre_phase(p, lds, wave, lane);
#endif
    xcd_barrier(gbar);
    {
        int b_ = blockIdx.x; asm volatile("" : "+s"(b_));
        int lane_s = lane; asm volatile("" : "+v"(lane_s));
        const int b = b_, G = gridDim.x;
        const bool split = (G >= 128), prompt_wave = split && wave == 4 && b < 128;
        f32x4 Hs[4];
#pragma unroll
        for (int i = 0; i < 4; ++i) Hs[i] = (f32x4){0.f, 0.f, 0.f, 0.f};
        const int pch = b >> 2;
        if (wave < 4) { for (int q = b; q < 256; q += G) { f32x4 Hq[4];
#pragma unroll
                for (int i = 0; i < 4; ++i) Hq[i] = (f32x4){0.f, 0.f, 0.f, 0.f};
                rwkv_scan_chain(p, q & 1, 2 + (q >> 4), (q >> 1) & 7, wave, lane_s, 0, T_SAMPLE / 64, Hq); } }
        else if (prompt_wave) rwkv_scan_chain(p, pch & 1, pch >> 4, (pch >> 1) & 7, b & 3, lane_s, 0, 64, Hs);
        else if (!split && wave == 4) { for (int pw = b; pw < 128; pw += G) { const int ch = pw >> 2; f32x4 Hq[4];
#pragma unroll
                for (int i = 0; i < 4; ++i) Hq[i] = (f32x4){0.f, 0.f, 0.f, 0.f};
                rwkv_scan_chain(p, ch & 1, ch >> 4, (ch >> 1) & 7, pw & 3, lane_s, 0, T_PROMPT / 64, Hq); } }
        xcd_barrier(gbar);
        const int nb7 = split ? 128 : 0;
        const int n_prompt_items = 2 * (T_PROMPT / 64) * NH;
        if (prompt_wave) rwkv_scan_chain(p, pch & 1, pch >> 4, (pch >> 1) & 7, b & 3, lane_s, 64, T_PROMPT / 64, Hs);
        else {
            const int slot = (b < nb7) ? b * 7 + (wave < 4 ? wave : wave - 1) : nb7 * 7 + (b - nb7) * 8 + wave;
            mix_phase3(p, lds, wave, lane_s, n_prompt_items, NGCHUNK * NH, slot, nb7 * 7 + (G - nb7) * 8);
        }
        xcd_barrier(gbar);
        mix_phase3(p, lds, wave, lane_s, 0, n_prompt_items, b * NWAVES + wave, G * NWAVES);
    }
    xcd_barrier(gbar);
#ifndef NO_G2
    { pg8::Gemm g{(const pg8::bf16_t*)(p.ws + WS_MIXED), (const pg8::bf16_t*)(p.ws + WS_WOUTT), M_TOK, DM, DM, DRW, (const pg8::bf16_t*)(p.ws + WS_YA), DRW / 64};
      pg8::StaticOrder S; S.init(M_TOK, DM, (int)gridDim.x, (int)blockIdx.x);
      pg8::EpiResF32 E{p.x_prompt, p.x_sample, p.out};
      pg8::gemm_phase<pg8::EpiResF32, pg8::StaticOrder>((PG8_LAS unsigned char*)lds, g, S, E, nullptr); }
#endif
}

extern "C" void kernel_launch(void* const* d_in, const int* in_sizes, int n_in, void* d_out, int out_size,
                              void* d_ws, size_t ws_size, hipStream_t stream) {
    static int grid_blocks = 0;
    if (grid_blocks == 0) {
        if (n_in != 18 || out_size != M_TOK * DM || ws_size < WS_END) {
            fprintf(stderr, "kernel_launch: unexpected shapes (n_in %d out %d ws %zu need %zu); nothing launched\n", n_in, out_size, ws_size, (size_t)WS_END);
            grid_blocks = -1; return; }
        int dev = 0, cus = 0, per_cu = 0;
        (void)hipGetDevice(&dev);
        (void)hipDeviceGetAttribute(&cus, hipDeviceAttributeMultiprocessorCount, dev);
        (void)hipFuncSetAttribute((const void*)fwd_megakernel, hipFuncAttributeMaxDynamicSharedMemorySize, LDS_BYTES);
        (void)hipOccupancyMaxActiveBlocksPerMultiprocessor(&per_cu, fwd_megakernel, NTHREADS, LDS_BYTES);
        if (per_cu < 1) { fprintf(stderr, "kernel_launch: occupancy query says %d blocks per CU\n", per_cu); per_cu = 1; }
        grid_blocks = cus;
    }
    if (grid_blocks < 0) return;
    Params p{};
    p.x_prompt = (const float*)d_in[0]; p.x_sample = (const float*)d_in[1]; p.norm_g = (const float*)d_in[2]; p.w_in = (const float*)d_in[3];
    p.shift_mu = (const float*)d_in[4]; p.w0 = (const float*)d_in[5]; p.w_up = (const float*)d_in[6]; p.a0 = (const float*)d_in[7]; p.a_up = (const float*)d_in[8];
    p.k_k = (const float*)d_in[9]; p.k_a = (const float*)d_in[10]; p.r_k = (const float*)d_in[11]; p.lnx_g = (const float*)d_in[12]; p.lnx_b = (const float*)d_in[13];
    p.q_norm_g = (const float*)d_in[14]; p.k_norm_g = (const float*)d_in[15]; p.rpb = (const float*)d_in[16]; p.w_out = (const float*)d_in[17];
    p.out = (float*)d_out; p.ws = (unsigned char*)d_ws;
    if (hipMemsetAsync((char*)d_ws + WS_CTL, 0, 1u << 20, stream) != hipSuccess) { fprintf(stderr, "kernel_launch: memset of control words failed\n"); return; }
    void* args[] = {&p};
    hipError_t e = hipLaunchCooperativeKernel((void*)fwd_megakernel, dim3(grid_blocks), dim3(NTHREADS), args, LDS_BYTES, stream);
    if (e != hipSuccess) fprintf(stderr, "cooperative launch failed: %s (grid %d)\n", hipGetErrorString(e), grid_blocks);
}
```

```cpp
#include <hip/hip_runtime.h>
#include <hip/hip_cooperative_groups.h>
#include <cstdio>
#include <cstdint>
namespace cg = cooperative_groups;
#define PROBE_REP_PRE 1
#define PROBE_REP_NA 1
#define PROBE_REP_MIX 1
#define PROBE_REP_P0 1

namespace pg8 {
#define PG8_LAS __attribute__((address_space(3)))
typedef unsigned short bf16_t;
typedef short bf16x8 __attribute__((ext_vector_type(8)));
typedef float f32x4 __attribute__((ext_vector_type(4)));
typedef unsigned u32x4 __attribute__((ext_vector_type(4)));
constexpr int BM = 256, BK = 64, HALF = 128, HTB = HALF * BK * 2  , STAGE_BYTES = 8 * HTB, NXCD = 8, WGM = 8;

__host__ __device__ __forceinline__ int lds_byte(int r, int c) { const int st = (r >> 4) * 2 + (c >> 5), rr = r & 15, cc = c & 31, ob = rr * 64 + cc * 2; return st * 1024 + (ob ^ (((ob >> 9) & 1) << 5)); }
__host__ __device__ __forceinline__ void stage_rc(int b, int& R, int& C) { const int st = b / 1024, sb = b % 1024, swz = sb ^ (((sb >> 9) & 1) << 5); R = (st >> 1) * 16 + swz / 64; C = (st & 1) * 32 + (swz % 64) / 2; }
__host__ __device__ __forceinline__ int perm32(int rho) { const int n = rho >> 4, i = rho & 15; return 8 * (i >> 2) + 4 * n + (i & 3); }

struct Unit { int pm, pn; int half; };
struct Gemm { const bf16_t* A; const bf16_t* Bt; int M, N, K; int lda; const bf16_t* A2; int ksplit; };

struct StaticOrder {
    int nM, nN, nwg, G, c, half_last;
    __host__ __device__ void init(int M, int N, int G_, int c_, int half_last_ = 0) { nM = M / BM; nN = N / BM; nwg = nM * nN; G = G_; c = c_; half_last = half_last_; }
    __host__ __device__ bool next(int i, Unit& u) const {
        const long L = (long)i * G + c; if (L >= nwg) return false;
        int wgid = (int)L; { const int q = nwg / NXCD, r = nwg % NXCD, xcd = wgid % NXCD, off = wgid / NXCD; wgid = (xcd < r ? xcd * (q + 1) : r * (q + 1) + (xcd - r) * q) + off; }
        const int nig = WGM * nN, gid = wgid / nig, fm = gid * WGM, gsz = (nM - fm) < WGM ? (nM - fm) : WGM;
        u.pm = fm + ((wgid % nig) % gsz); u.pn = (wgid % nig) / gsz; u.half = (half_last && u.pn == nN - 1) ? 1 : 0; return true;
    }
    __device__ __forceinline__ void a_ready(const Unit&) const {}
    __device__ __forceinline__ void done(const Unit&) const {}
};
__device__ __forceinline__ unsigned cvt_pk_bf16(float lo, float hi) { unsigned r; asm volatile("v_cvt_pk_bf16_f32 %0, %1, %2" : "=v"(r) : "v"(lo), "v"(hi)); return r; }
typedef float f32x2 __attribute__((ext_vector_type(2)));
__device__ __forceinline__ f32x2 gelu_pk(f32x2 v) {
    const f32x2 av = __builtin_elementwise_abs(v), d = av * 0.2316418882f + 1.0f;
    f32x2 t; t.x = __builtin_amdgcn_rcpf(d.x); t.y = __builtin_amdgcn_rcpf(d.y);
    f32x2 q = t * 0.5307027145f + (-0.7265760135f); q = q * t + 0.7107068705f; q = q * t + (-0.142248368f); q = q * t + 0.127414796f; q = q * t;
    const f32x2 s = (v * v) * (-0.72134752044f);
    f32x2 e; e.x = __builtin_amdgcn_exp2f(s.x); e.y = __builtin_amdgcn_exp2f(s.y);
    const f32x2 m = v * (q * e), r = v - m;
    f32x2 o; o.x = v.x < 0.f ? m.x : r.x; o.y = v.y < 0.f ? m.y : r.y; return o;
}
struct EpiF32 {
    static constexpr bool PERM = false, AFTER_DRAIN = false, SPLIT = false;
    float* C; int ldc; const float* bias;
    __device__ __forceinline__ void operator()(const f32x4 (&acc)[2][2][4][2], const Unit& u, int wr, int wc, int fr, int fq) const {
        const int row0 = u.pm * BM + wr * 64 + fr, col0 = u.pn * BM + wc * 32 + 4 * fq;
        f32x4 bv[2][2];
#pragma unroll
        for (int bj = 0; bj < 2; ++bj)
#pragma unroll
            for (int n = 0; n < 2; ++n) bv[bj][n] = bias ? *(const f32x4*)(bias + col0 + bj * HALF + n * 16) : (f32x4){0.f, 0.f, 0.f, 0.f};
#pragma unroll
        for (int ai = 0; ai < 2; ++ai)
#pragma unroll
            for (int m = 0; m < 4; ++m) { float* rowp = C + (size_t)(row0 + ai * HALF + m * 16) * ldc + col0;
#pragma unroll
                for (int bj = 0; bj < 2; ++bj)
#pragma unroll
                    for (int n = 0; n < 2; ++n) *(f32x4*)(rowp + bj * HALF + n * 16) = acc[ai][bj][m][n] + bv[bj][n]; }
    }
};
template <int ACT  > struct EpiBf16 {
    static constexpr bool PERM = true, AFTER_DRAIN = false, SPLIT = (ACT == 0);
    bf16_t* O; int ldc; const float* bias; int split_cols; size_t split_stride;
    __device__ __forceinline__ void quad(const f32x4 (&acc)[2][2][4][2], const Unit& u, int wr, int wc, int fr, int fq, int ai, int bj) const {
        const int col = u.pn * BM + wc * 32 + 8 * fq + bj * HALF;
        bf16_t* rowp0 = O + (size_t)(col >> 5) * split_stride + (size_t)(u.pm * BM + wr * 64 + fr + ai * HALF) * 32 + (col & 31);
#pragma unroll
        for (int m = 0; m < 4; ++m) { const f32x4 v0 = acc[ai][bj][m][0], v1 = acc[ai][bj][m][1];
            u32x4 w; w.x = cvt_pk_bf16(v0[0], v0[1]); w.y = cvt_pk_bf16(v0[2], v0[3]); w.z = cvt_pk_bf16(v1[0], v1[1]); w.w = cvt_pk_bf16(v1[2], v1[3]);
            *(u32x4*)(rowp0 + (size_t)(m * 16) * 32) = w; }
    }
    __device__ __forceinline__ void operator()(const f32x4 (&acc)[2][2][4][2], const Unit& u, int wr, int wc, int fr, int fq) const {
        const int row0 = u.pm * BM + wr * 64 + fr; int colt = u.pn * BM; bf16_t* base = O;
        if (split_cols) { const int t = colt / split_cols; base += (size_t)t * split_stride; colt -= t * split_cols; }
        const int col0 = colt + wc * 32 + 8 * fq, bcol0 = u.pn * BM + wc * 32 + 8 * fq;
        f32x4 bv[2][2];
#pragma unroll
        for (int bj = 0; bj < 2; ++bj)
#pragma unroll
            for (int n = 0; n < 2; ++n) bv[bj][n] = bias ? *(const f32x4*)(bias + bcol0 + bj * HALF + 4 * n) : (f32x4){0.f, 0.f, 0.f, 0.f};
#pragma unroll
        for (int ai = 0; ai < 2; ++ai)
#pragma unroll
            for (int m = 0; m < 4; ++m) { bf16_t* rowp = base + (size_t)(row0 + ai * HALF + m * 16) * ldc + col0;
#pragma unroll
                for (int bj = 0; bj < 2; ++bj) { if (bj == 1 && u.half) continue;
                    f32x4 v0 = acc[ai][bj][m][0] + bv[bj][0], v1 = acc[ai][bj][m][1] + bv[bj][1];
                    if (ACT == 1) { f32x2 a = gelu_pk((f32x2){v0[0], v0[1]}), b = gelu_pk((f32x2){v0[2], v0[3]}), c = gelu_pk((f32x2){v1[0], v1[1]}), d = gelu_pk((f32x2){v1[2], v1[3]});
                        v0 = (f32x4){a.x, a.y, b.x, b.y}; v1 = (f32x4){c.x, c.y, d.x, d.y}; }
                    if (ACT == 2) {
#pragma unroll
                        for (int j = 0; j < 4; ++j) { v0[j] = 0.5f * v0[j] * (1.0f + erff(v0[j] * 0.70710678f)); v1[j] = 0.5f * v1[j] * (1.0f + erff(v1[j] * 0.70710678f)); } }
                    u32x4 w; w.x = cvt_pk_bf16(v0[0], v0[1]); w.y = cvt_pk_bf16(v0[2], v0[3]); w.z = cvt_pk_bf16(v1[0], v1[1]); w.w = cvt_pk_bf16(v1[2], v1[3]);
                    *(u32x4*)(rowp + bj * HALF) = w; } }
    }
};
struct EpiResF32 {
    static constexpr bool PERM = false, AFTER_DRAIN = false, SPLIT = false;
    const float* xp; const float* xs; float* C;
    __device__ __forceinline__ void operator()(const f32x4 (&acc)[2][2][4][2], const Unit& u, int wr, int wc, int fr, int fq) const {
        const bool lo = fr < 8;
        const int rowA = u.pm * BM + wr * 64 + (fr & 7), col0 = u.pn * BM + wc * 32 + 4 * fq + (lo ? 0 : 16);
        const float* xb = (u.pm < 128 ? xp + (size_t)rowA * 1024 : xs + (size_t)(rowA - 32768) * 1024) + col0;
        float* cb = C + (size_t)rowA * 1024 + col0;
#define RES_ROR8(v_) __builtin_bit_cast(float, __builtin_amdgcn_update_dpp(0, __builtin_bit_cast(int, (v_)), 0x128, 0xF, 0xF, true))
#define RES_LOAD(xv_, ai_) do { _Pragma("unroll") for (int m = 0; m < 4; ++m) _Pragma("unroll") for (int bj = 0; bj < 2; ++bj) _Pragma("unroll") for (int ab = 0; ab < 2; ++ab) \
            xv_[m][bj][ab] = *(const f32x4*)(xb + (size_t)((ai_) * HALF + m * 16 + 8 * ab) * 1024 + bj * HALF); } while (0)
#define RES_ADD(xv_, ai_) do { _Pragma("unroll") for (int m = 0; m < 4; ++m) _Pragma("unroll") for (int bj = 0; bj < 2; ++bj) { \
            const f32x4 n0 = acc[ai_][bj][m][0], n1 = acc[ai_][bj][m][1]; \
            _Pragma("unroll") for (int e = 0; e < 4; ++e) { const float t_ = lo ? n1[e] : n0[e]; const float tp_ = RES_ROR8(t_); xv_[m][bj][0][e] += lo ? n0[e] : tp_; xv_[m][bj][1][e] += lo ? tp_ : n1[e]; } } } while (0)
#define RES_STORE(xv_, ai_) do { _Pragma("unroll") for (int m = 0; m < 4; ++m) _Pragma("unroll") for (int bj = 0; bj < 2; ++bj) _Pragma("unroll") for (int ab = 0; ab < 2; ++ab) \
            __builtin_nontemporal_store(xv_[m][bj][ab], (f32x4*)(cb + (size_t)((ai_) * HALF + m * 16 + 8 * ab) * 1024 + bj * HALF)); } while (0)
        f32x4 xa[4][2][2], xc[4][2][2];
        RES_LOAD(xa, 0);
        __builtin_amdgcn_sched_barrier(0);
        RES_ADD(xa, 0);
        __builtin_amdgcn_sched_barrier(0);
        RES_LOAD(xc, 1);
        __builtin_amdgcn_sched_barrier(0);
        RES_STORE(xa, 0);
        __builtin_amdgcn_sched_barrier(0);
        RES_ADD(xc, 1);
        __builtin_amdgcn_sched_barrier(0);
        RES_STORE(xc, 1);
        __builtin_amdgcn_sched_barrier(0);
#undef RES_LOAD
#undef RES_ADD
#undef RES_STORE
#undef RES_ROR8
    }
};
template <class Epi, class Sched, bool STAMP = false>
__device__ __forceinline__ void gemm_phase(PG8_LAS unsigned char* lds, const Gemm g, const Sched& S, const Epi& E, unsigned long long* stamps) {
    int tid_ = threadIdx.x; asm volatile("" : "+v"(tid_));
    const int tid = tid_, wid = __builtin_amdgcn_readfirstlane(tid >> 6), lane = tid & 63, wr = wid >> 2, wc = wid & 3, fr = lane & 15, fq = lane >> 4;
    const int K = g.K, nt = K / BK;
    int ts_lo = 0, ts_hi = 0, nts = 0; const unsigned long long rt_entry = STAMP ? (unsigned long long)wall_clock64() : 0ull;
#define PG8_STAMP() do { if (STAMP && wid == 0 && nts < 64) { const unsigned long long _c = (unsigned long long)clock64(); \
        ts_lo = (lane == nts) ? (int)(unsigned)_c : ts_lo; ts_hi = (lane == nts) ? (int)(unsigned)(_c >> 32) : ts_hi; ++nts; } } while (0)
    PG8_STAMP();
    unsigned voffA[2], voffB[2];
#pragma unroll
    for (int i = 0; i < 2; ++i) { int R, C; stage_rc(tid * 16 + i * 8192, R, C); const int Rb = Epi::PERM ? ((R & ~31) + perm32(R & 31)) : R;
        voffA[i] = (unsigned)(R * g.lda + C) * 2u; voffB[i] = (unsigned)(Rb * K + C) * 2u; }
    const size_t kstep = (size_t)(BK * 2);
    const size_t hstep = (size_t)HALF * K * 2;
    const size_t tstep = 2 * hstep;
    const size_t hstepA = (size_t)HALF * g.lda * 2, tstepA = 2 * hstepA;
    const int ks = g.ksplit;
#define PG8_AK(lo, hi, t) (((t) < ks ? (lo) : (hi)) + (size_t)(t) * kstep)
    const unsigned ldsw = (unsigned)wid * 1024u;
    const int aoff = lds_byte(wr * 64 + fr, fq * 8), boff = lds_byte(wc * 32 + fr, fq * 8);
#define PG8_SA(b, h) (((b) * 2 + (h)) * HTB)
#define PG8_SB(b, h) ((4 + (b) * 2 + (h)) * HTB)
#define PG8_STAGE(bufoff, gbase, voff) do { _Pragma("unroll") for (int _i = 0; _i < 2; ++_i) \
        __builtin_amdgcn_global_load_lds((const unsigned*)((const char*)(gbase) + (voff)[_i]), (PG8_LAS unsigned*)(lds + (bufoff) + ldsw + _i * 8192), 16, 0, 0); } while (0)
#define PG8_LDA(dst, b, h) do { _Pragma("unroll") for (int m = 0; m < 4; ++m) _Pragma("unroll") for (int k = 0; k < 2; ++k) dst[m][k] = *(const PG8_LAS bf16x8*)(lds + PG8_SA(b, h) + aoff + m * 2048 + k * 1024); } while (0)
#define PG8_LDB(dst, b, h) do { _Pragma("unroll") for (int n = 0; n < 2; ++n) _Pragma("unroll") for (int k = 0; k < 2; ++k) dst[n][k] = *(const PG8_LAS bf16x8*)(lds + PG8_SB(b, h) + boff + n * 2048 + k * 1024); } while (0)
#define PG8_MMA(ai, bj, At, Bt) do { __builtin_amdgcn_s_setprio(1); _Pragma("unroll") for (int m = 0; m < 4; ++m) _Pragma("unroll") for (int n = 0; n < 2; ++n) _Pragma("unroll") for (int k = 0; k < 2; ++k) \
        acc[ai][bj][m][n] = __builtin_amdgcn_mfma_f32_16x16x32_bf16(Bt[n][k], At[m][k], acc[ai][bj][m][n], 0, 0, 0); __builtin_amdgcn_s_setprio(0); } while (0)
#define PG8_WAIT_V(n) asm volatile("s_waitcnt vmcnt(" #n ")" ::: "memory")
#define PG8_WAIT_L(n) asm volatile("s_waitcnt lgkmcnt(" #n ")" ::: "memory")
#define PG8_BAR __builtin_amdgcn_s_barrier()
#define PG8_SCHED __builtin_amdgcn_sched_barrier(0)
    Unit cur, nxt; int ui = 0;
    if (!S.next(0, cur)) return;
    f32x4 acc[2][2][4][2];
#pragma unroll
    for (int a = 0; a < 2; ++a)
#pragma unroll
        for (int b = 0; b < 2; ++b)
#pragma unroll
            for (int m = 0; m < 4; ++m)
#pragma unroll
                for (int n = 0; n < 2; ++n) acc[a][b][m][n] = (f32x4){0.f, 0.f, 0.f, 0.f};
    bf16x8 At[4][2], B0[2][2], B1[2][2];
    const char* cA = (const char*)g.A + (size_t)cur.pm * tstepA; const char* cA2 = (const char*)g.A2 + (size_t)cur.pm * tstepA - (size_t)ks * kstep; const char* cB = (const char*)g.Bt + (size_t)cur.pn * tstep;
    S.a_ready(cur);
    PG8_STAGE(PG8_SB(0, 0), cB, voffB); PG8_STAGE(PG8_SA(0, 0), cA, voffA); PG8_STAGE(PG8_SB(0, 1), cB + hstep, voffB); PG8_STAGE(PG8_SA(0, 1), cA + hstepA, voffA);
    if (wr == 1) PG8_BAR;
    PG8_WAIT_V(4); PG8_BAR;
    PG8_STAGE(PG8_SB(1, 0), cB + kstep, voffB); PG8_STAGE(PG8_SA(1, 0), cA + kstep, voffA); PG8_STAGE(PG8_SB(1, 1), cB + hstep + kstep, voffB);
    PG8_WAIT_V(6); PG8_BAR;
    PG8_STAMP();
    for (;;) {
        const bool has_next = S.next(ui + 1, nxt);
        const char* nA = has_next ? (const char*)g.A + (size_t)nxt.pm * tstepA : cA; const char* nA2 = has_next ? (const char*)g.A2 + (size_t)nxt.pm * tstepA - (size_t)ks * kstep : cA2;
        const char* nB = has_next ? (const char*)g.Bt + (size_t)nxt.pn * tstep : cB;
        const bool hb = cur.half != 0;
        for (int t = 0; t < nt; t += 2) {
            const bool last = (t == nt - 2);
            const char* a1 = PG8_AK(cA, cA2, t + 1);
            const char* a2 = last ? nA : PG8_AK(cA, cA2, t + 2); const char* b2 = last ? nB : cB + (size_t)(t + 2) * kstep;
            const char* a3 = a2 + kstep; const char* b3 = b2 + kstep;
            if (last && has_next) S.a_ready(nxt);
            PG8_LDB(B0, 0, 0); PG8_SCHED; PG8_LDA(At, 0, 0); PG8_STAGE(PG8_SA(1, 1), a1 + hstepA, voffA);
            PG8_WAIT_L(8); PG8_BAR; PG8_WAIT_L(0); PG8_MMA(0, 0, At, B0); PG8_BAR; PG8_SCHED;
            PG8_LDB(B1, 0, 1); PG8_STAGE(PG8_SB(0, 0), b2, voffB);
            PG8_BAR; PG8_WAIT_L(0); if (!hb) PG8_MMA(0, 1, At, B1); PG8_BAR;
            PG8_LDA(At, 0, 1); PG8_STAGE(PG8_SA(0, 0), a2, voffA);
            PG8_BAR; PG8_WAIT_L(0); PG8_MMA(1, 0, At, B0); PG8_BAR; PG8_SCHED;
            PG8_STAGE(PG8_SB(0, 1), b2 + hstep, voffB);
            PG8_WAIT_V(6); PG8_BAR; if (!hb) PG8_MMA(1, 1, At, B1); PG8_BAR;
            PG8_LDB(B0, 1, 0); PG8_SCHED; PG8_LDA(At, 1, 0); PG8_STAGE(PG8_SA(0, 1), a2 + hstepA, voffA);
            PG8_WAIT_L(8); PG8_BAR; PG8_WAIT_L(0); PG8_MMA(0, 0, At, B0); PG8_BAR; PG8_SCHED;
            const bool lsp = Epi::SPLIT && last;
            PG8_LDB(B1, 1, 1); PG8_STAGE(PG8_SB(1, 0), b3, voffB);
            if constexpr (Epi::SPLIT) { if (lsp) E.quad(acc, cur, wr, wc, fr, fq, 0, 0); }
            PG8_BAR; PG8_WAIT_L(0); if (!hb) PG8_MMA(0, 1, At, B1); PG8_BAR;
            PG8_LDA(At, 1, 1); PG8_STAGE(PG8_SA(1, 0), a3, voffA);
            if constexpr (Epi::SPLIT) { if (lsp && !hb) E.quad(acc, cur, wr, wc, fr, fq, 0, 1); }
            PG8_BAR; PG8_WAIT_L(0); PG8_MMA(1, 0, At, B0); PG8_BAR; PG8_SCHED;
            PG8_STAGE(PG8_SB(1, 1), b3 + hstep, voffB);
            if constexpr (Epi::SPLIT) { if (lsp) E.quad(acc, cur, wr, wc, fr, fq, 1, 0); }
            if (lsp) { if (hb) PG8_WAIT_V(14); else PG8_WAIT_V(18); } else PG8_WAIT_V(6);
            PG8_BAR; if (!hb) PG8_MMA(1, 1, At, B1); PG8_BAR;
        }
        PG8_STAMP();
        if constexpr (Epi::SPLIT) { if (!hb) E.quad(acc, cur, wr, wc, fr, fq, 1, 1); S.done(cur); }
        else if constexpr (!Epi::AFTER_DRAIN) { E(acc, cur, wr, wc, fr, fq); S.done(cur); }
        PG8_STAMP();
        if (!has_next) break;
#pragma unroll
        for (int a = 0; a < 2; ++a)
#pragma unroll
            for (int b = 0; b < 2; ++b)
#pragma unroll
                for (int m = 0; m < 4; ++m)
#pragma unroll
                    for (int n = 0; n < 2; ++n) acc[a][b][m][n] = (f32x4){0.f, 0.f, 0.f, 0.f};
        cur = nxt; cA = nA; cA2 = nA2; cB = nB; ++ui;
    }
    PG8_WAIT_V(0);
    if (wr == 0) PG8_BAR;
    PG8_BAR;
    if constexpr (Epi::AFTER_DRAIN) { E.fused(acc, cur, wr, wc, fr, fq, lds, wid, lane); S.done(cur); }
    PG8_STAMP();
    if (STAMP && wid == 0) { stamps[lane] = lane < nts ? (((unsigned long long)(unsigned)ts_hi << 32) | (unsigned)ts_lo) : 0ull;
        if (lane == 62) stamps[62] = rt_entry; if (lane == 63) stamps[63] = (unsigned long long)wall_clock64(); }
#undef PG8_STAMP
#undef PG8_AK
#undef PG8_SA
#undef PG8_SB
#undef PG8_STAGE
#undef PG8_LDA
#undef PG8_LDB
#undef PG8_MMA
#undef PG8_WAIT_V
#undef PG8_WAIT_L
#undef PG8_BAR
#undef PG8_SCHED
}
}
#define GAS __attribute__((address_space(1)))
#define LAS __attribute__((address_space(3)))
typedef unsigned short bf16;
typedef float f32x4 __attribute__((ext_vector_type(4)));
typedef unsigned u32x4 __attribute__((ext_vector_type(4)));
typedef unsigned u32x2 __attribute__((ext_vector_type(2)));
constexpr int DM = 1024, M_TOK = 98304, M_PROMPT = 32768, T_PROMPT = 16384, T_SAMPLE = 4096, NSEQ = 18;
constexpr int DIN = 4224, DINP = 4352, DRW = 512, NH = 8, HD = 64;
constexpr int C_R = 0, C_K = 512, C_V = 1024, C_G = 1536, C_WDN = 2048, C_ADN = 2112, C_AQ = 2176, C_AK = 2688, C_AV = 3200, C_AG = 3712;
constexpr int NWAVES = 8, NTHREADS = 512;
constexpr size_t ZSLAB = (size_t)98304 * 32;
constexpr int ZW = 32;
#define ZS(Z_, m_, col_) ((const bf16*)((const char*)(Z_) + (unsigned)((unsigned)((col_) >> 5) * (unsigned)(ZSLAB * 2) + (unsigned)(m_) * 64u + (unsigned)((col_) & 31) * 2u)))
constexpr int LDS_BYTES = 163840;
constexpr size_t MiB = 1u << 20;
constexpr size_t WS_CTL = 0;
constexpr size_t WS_WINT = 2 * MiB;
constexpr size_t WS_WOUTT = 11 * MiB;
constexpr size_t WS_WUPT = 13 * MiB;
constexpr size_t WS_AUPT = 13 * MiB + 131072;
constexpr size_t WS_BONUS = 14 * MiB;
constexpr size_t WS_Z = 20 * MiB;
constexpr size_t CMB = (size_t)2 * 1536 * 8 * 8192;
constexpr size_t WS_CM_P = WS_Z + (size_t)M_TOK * DINP * 2;
constexpr size_t WS_CM_RP = WS_CM_P + CMB;
constexpr size_t WS_CM_G = WS_CM_RP + CMB;
constexpr size_t WS_MIXED = WS_CM_P;
constexpr size_t WS_YA = WS_CM_G + CMB;
constexpr size_t WS_LD = WS_YA + (size_t)M_TOK * DRW * 2;
constexpr size_t WS_RN = WS_LD + (size_t)M_TOK * 128 * 2;
constexpr size_t WS_END = WS_RN + (size_t)M_TOK * NH * 4;

struct Params {
    const float* x_prompt; const float* x_sample; const float* norm_g; const float* w_in; const float* shift_mu; const float* w0; const float* w_up;
    const float* a0; const float* a_up; const float* k_k; const float* k_a; const float* r_k; const float* lnx_g; const float* lnx_b;
    const float* q_norm_g; const float* k_norm_g; const float* rpb; const float* w_out;
    float* out; unsigned char* ws;
};

__device__ __forceinline__ unsigned f2bf(float f) { unsigned u = __builtin_bit_cast(unsigned, f); return (u + 0x7fffu + ((u >> 16) & 1u)) >> 16; }
__device__ __forceinline__ unsigned pk2(float lo, float hi) { return f2bf(lo) | (f2bf(hi) << 16); }
__device__ __forceinline__ float bf2f(unsigned b) { return __builtin_bit_cast(float, b << 16); }
__device__ __forceinline__ float bflo(unsigned w) { return __builtin_bit_cast(float, w << 16); }
__device__ __forceinline__ float bfhi(unsigned w) { return __builtin_bit_cast(float, w & 0xffff0000u); }
__device__ __forceinline__ float sigmoidf_(float x) { return 1.0f / (1.0f + __expf(-x)); }
__device__ __forceinline__ float fsigmoid(float x) { return __builtin_amdgcn_rcpf(1.0f + __builtin_amdgcn_exp2f(-1.4426950408889634f * x)); }
__device__ __forceinline__ float dpp_sum16(float v) {
    v += __builtin_bit_cast(float, __builtin_amdgcn_update_dpp(0, __builtin_bit_cast(int, v), 0xB1, 0xF, 0xF, true));
    v += __builtin_bit_cast(float, __builtin_amdgcn_update_dpp(0, __builtin_bit_cast(int, v), 0x4E, 0xF, 0xF, true));
    v += __builtin_bit_cast(float, __builtin_amdgcn_update_dpp(0, __builtin_bit_cast(int, v), 0x141, 0xF, 0xF, true));
    v += __builtin_bit_cast(float, __builtin_amdgcn_update_dpp(0, __builtin_bit_cast(int, v), 0x140, 0xF, 0xF, true));
    return v;
}
__device__ __forceinline__ float dpp_sum8(float v) {
    v += __builtin_bit_cast(float, __builtin_amdgcn_update_dpp(0, __builtin_bit_cast(int, v), 0xB1, 0xF, 0xF, true));
    v += __builtin_bit_cast(float, __builtin_amdgcn_update_dpp(0, __builtin_bit_cast(int, v), 0x4E, 0xF, 0xF, true));
    v += __builtin_bit_cast(float, __builtin_amdgcn_update_dpp(0, __builtin_bit_cast(int, v), 0x141, 0xF, 0xF, true));
    return v;
}
__device__ __forceinline__ float add_xor16(float v) { const auto r = __builtin_amdgcn_permlane16_swap(__float_as_uint(v), __float_as_uint(v), false, false); return __uint_as_float(r[0]) + __uint_as_float(r[1]); }
__device__ __forceinline__ float add_xor32(float v) { const auto r = __builtin_amdgcn_permlane32_swap(__float_as_uint(v), __float_as_uint(v), false, false); return __uint_as_float(r[0]) + __uint_as_float(r[1]); }
__device__ __forceinline__ float wave_sum(float v) { return add_xor32(add_xor16(dpp_sum16(v))); }
__device__ __forceinline__ float max_xor16(float v) { const auto r = __builtin_amdgcn_permlane16_swap(__float_as_uint(v), __float_as_uint(v), false, false); return fmaxf(__uint_as_float(r[0]), __uint_as_float(r[1])); }
__device__ __forceinline__ float max_xor32(float v) { const auto r = __builtin_amdgcn_permlane32_swap(__float_as_uint(v), __float_as_uint(v), false, false); return fmaxf(__uint_as_float(r[0]), __uint_as_float(r[1])); }
__device__ __forceinline__ float dpp_rs16x4(float a0, float a1, float a2, float a3, int cl) {
#define DPPF(x, ctrl) __builtin_bit_cast(float, __builtin_amdgcn_update_dpp(0, __builtin_bit_cast(int, (x)), (ctrl), 0xF, 0xF, true))
    const bool p0 = (cl & 1) != 0, p1 = (cl & 2) != 0;
    const float k0 = p0 ? a2 : a0, k1 = p0 ? a3 : a1, s0 = p0 ? a0 : a2, s1 = p0 ? a1 : a3;
    const float b0 = k0 + DPPF(s0, 0xB1), b1 = k1 + DPPF(s1, 0xB1);
    const float k = p1 ? b1 : b0, sx = p1 ? b0 : b1;
    float c = k + DPPF(sx, 0x4E);
    c += DPPF(c, 0x124);
    c += DPPF(c, 0x128);
#undef DPPF
    return c;
}
__device__ __forceinline__ void seq_of_token(int m, int& t, int& T) { if (m < M_PROMPT) { t = m & (T_PROMPT - 1); T = T_PROMPT; } else { t = (m - M_PROMPT) & (T_SAMPLE - 1); T = T_SAMPLE; } }
__device__ __forceinline__ void seq_info(int s, int& start, int& len) { if (s < 2) { start = s * T_PROMPT; len = T_PROMPT; } else { start = M_PROMPT + (s - 2) * T_SAMPLE; len = T_SAMPLE; } }

#define XB_TMO      128
#define XB_XCNT(j)  (256  + 64 * (j))
#define XB_XSUB(j)  (1280 + 64 * (j))
#define XB_XGEN(j)  (2304 + 64 * (j))
#define XB_TOP      3328
#define XB_TOPGEN   3392
#define XCD_BAR_WORDS 3456
#define XB_SPIN_CAP (1u << 18)

__device__ __forceinline__ unsigned xb_ld(unsigned* p)              { return __hip_atomic_load(p, __ATOMIC_RELAXED, __HIP_MEMORY_SCOPE_AGENT); }
__device__ __forceinline__ unsigned xb_add(unsigned* p, unsigned v) { return __hip_atomic_fetch_add(p, v, __ATOMIC_RELAXED, __HIP_MEMORY_SCOPE_AGENT); }
__device__ __forceinline__ unsigned xb_xcc_id() { return (unsigned)__builtin_amdgcn_s_getreg((3 << 11) | 20) & 0xFu; }
#define XB_SPIN(cond, bar) do { unsigned _sp = 0; while (cond) { __builtin_amdgcn_s_sleep(1); \
    if ((++_sp & 255u) == 0u) { if (xb_ld(&(bar)[XB_TMO])) break; if (_sp > XB_SPIN_CAP) { atomicAdd(&(bar)[XB_TMO], 1u); break; } } } } while (0)

struct XcdBarrier {
    unsigned* bar; unsigned x;
    volatile LAS unsigned* st;
};

__device__ __forceinline__ XcdBarrier xcd_barrier_post(unsigned* bar, volatile LAS unsigned* st) {
    XcdBarrier b; b.bar = bar; b.x = xb_xcc_id(); b.st = st;
    if (threadIdx.x == 0) (void)xb_add(&bar[XB_XCNT(b.x)], 1u);
    return b;
}
__device__ __forceinline__ void xcd_barrier_complete(unsigned* bar, unsigned x, unsigned& nloc, unsigned& nx) {
    const unsigned G = gridDim.x * gridDim.y * gridDim.z;
    unsigned sum, cnt, mine, sp = 0u;
    for (;;) {
        sum = 0u; cnt = 0u; mine = 0u;
#pragma unroll
        for (unsigned j = 0; j < 16; ++j) { const unsigned c = xb_ld(&bar[XB_XCNT(j)]); sum += c; cnt += (c > 0u) ? 1u : 0u; mine = (j == x) ? c : mine; }
        if (sum == G) break;
        __builtin_amdgcn_s_sleep(1);
        if ((++sp & 255u) == 0u) { if (xb_ld(&bar[XB_TMO])) break; if (sp > XB_SPIN_CAP) { atomicAdd(&bar[XB_TMO], 1u); break; } }
    }
    nloc = mine > 0u ? mine : 1u; nx = cnt > 0u ? cnt : 1u;
}

__device__ __forceinline__ void xcd_barrier(const XcdBarrier& b) {
    asm volatile("s_waitcnt vmcnt(0)" ::: "memory");
    __syncthreads();
    if (threadIdx.x == 0) {
        unsigned* bar = b.bar;
        __builtin_amdgcn_s_waitcnt(0);
        unsigned nloc = b.st[0], nx = b.st[1];
        if (nloc == 0u) { xcd_barrier_complete(bar, b.x, nloc, nx); b.st[0] = nloc; b.st[1] = nx; }
        const unsigned old = xb_add(&bar[XB_XSUB(b.x)], 1u);
        const unsigned gen = old / nloc;
        if (old + 1u == (gen + 1u) * nloc) {
            __builtin_amdgcn_fence(__ATOMIC_RELEASE, "agent");
            asm volatile("s_waitcnt vmcnt(0)" ::: "memory");
            const unsigned og = xb_add(&bar[XB_TOP], 1u);
            const unsigned tg = og / nx;
            if (og + 1u == (tg + 1u) * nx) xb_add(&bar[XB_TOPGEN], 1u);
            else XB_SPIN(xb_ld(&bar[XB_TOPGEN]) == tg, bar);
            __builtin_amdgcn_fence(__ATOMIC_ACQUIRE, "agent");
            xb_add(&bar[XB_XGEN(b.x)], 1u);
            asm volatile("s_waitcnt vmcnt(0)" ::: "memory");
        } else {
            XB_SPIN(xb_ld(&bar[XB_XGEN(b.x)]) == gen, bar);
            __builtin_amdgcn_fence(__ATOMIC_ACQUIRE, "agent");
            asm volatile("s_waitcnt vmcnt(0)" ::: "memory");
        }
    }
    __syncthreads();
}


__device__ __forceinline__ void p0_transpose_item(const float* W, int K, int N, bf16* WT, LAS float* scr, int item, int lane) {
    const int nblk = N / 32, kb = item / nblk, nb = item % nblk, k0 = 64 * kb, n0 = 32 * nb;
    float wv[32];
#pragma unroll
    for (int i = 0; i < 32; ++i) { const int kk = 2 * i + (lane >> 5); wv[i] = W[(size_t)(k0 + kk) * N + n0 + (lane & 31)]; }
#pragma unroll
    for (int i = 0; i < 32; ++i) { const int kk = 2 * i + (lane >> 5); scr[kk * 33 + (lane & 31)] = wv[i]; }
    asm volatile("s_waitcnt lgkmcnt(0)" ::: "memory");
    const int c = lane & 7;
#pragma unroll
    for (int j = 0; j < 4; ++j) { const int n = (lane >> 3) + 8 * j; const LAS float* s = scr + (8 * c) * 33 + n;
        u32x4 o; o.x = pk2(s[0 * 33], s[1 * 33]); o.y = pk2(s[2 * 33], s[3 * 33]); o.z = pk2(s[4 * 33], s[5 * 33]); o.w = pk2(s[6 * 33], s[7 * 33]);
        *(u32x4*)(WT + (size_t)(n0 + n) * K + k0 + 8 * c) = o; }
    asm volatile("s_waitcnt lgkmcnt(0)" ::: "memory");
}
__device__ __forceinline__ void p0_prologue(const Params& p, LAS unsigned char* lds, int wave, int lane) {
    LAS float* scr = (LAS float*)(lds + wave * 16384);
    const int gw = blockIdx.x * NWAVES + wave, NGW = gridDim.x * NWAVES;
    bf16* WinT = (bf16*)(p.ws + WS_WINT); bf16* WoutT = (bf16*)(p.ws + WS_WOUTT);
    constexpr int I_IN = (DM / 64) * (DIN / 32), I_OUT = (DM / 64) * (DM / 32);
    for (int it = gw; it < I_IN + I_OUT; it += NGW) {
        if (it < I_IN) p0_transpose_item(p.w_in, DM, DIN, WinT, scr, it, lane);
        else p0_transpose_item(p.w_out, DM, DM, WoutT, scr, it - I_IN, lane);
    }
    { bf16* wupT = (bf16*)(p.ws + WS_WUPT); bf16* aupT = (bf16*)(p.ws + WS_AUPT);
      for (int idx = gw * 64 + lane; idx < 2 * DRW * 64; idx += NGW * 64) {
          const int z = idx >> 15, rem = idx & 32767, hc = rem >> 6, l = rem & 63;
          wupT[idx] = (bf16)f2bf(-1.4426950408889634f * p.w_up[(size_t)(z * 64 + l) * DRW + hc]); aupT[idx] = (bf16)f2bf(-1.4426950408889634f * p.a_up[(size_t)(z * 64 + l) * DRW + hc]); } }
    { const size_t n16 = (size_t)(DINP - DIN) * DM * 2 / 16; u32x4* z = (u32x4*)(WinT + (size_t)DIN * DM);
      for (size_t i = (size_t)gw * 64 + lane; i < n16; i += (size_t)NGW * 64) z[i] = (u32x4){0u, 0u, 0u, 0u}; }
    bf16* Hb = (bf16*)p.out;
    const f32x4* gr = (const f32x4*)p.norm_g + lane;
    f32x4 gv[4];
#pragma unroll
    for (int j = 0; j < 4; ++j) gv[j] = gr[64 * j];
    for (int m = gw; m < M_TOK; m += NGW) {
        const float* xrow = (m < M_PROMPT) ? p.x_prompt + (size_t)m * DM : p.x_sample + (size_t)(m - M_PROMPT) * DM;
        const f32x4* xr = (const f32x4*)xrow + lane;
        f32x4 v[4]; float s = 0.f;
#pragma unroll
        for (int j = 0; j < 4; ++j) { v[j] = xr[64 * j]; s += (v[j].x * v[j].x + v[j].y * v[j].y) + (v[j].z * v[j].z + v[j].w * v[j].w); }
        const float rstd = 1.0f / sqrtf(wave_sum(s) * (1.0f / DM) + 1e-6f);
        unsigned long long* o8 = (unsigned long long*)(Hb + (size_t)m * DM) + lane;
#pragma unroll
        for (int j = 0; j < 4; ++j) { const f32x4 w = v[j] * rstd * gv[j]; o8[64 * j] = (unsigned long long)pk2(w.x, w.y) | ((unsigned long long)pk2(w.z, w.w) << 32); }
    }
}

__device__ __forceinline__ void qk_norm_phase(const Params& p, int wave, int lane) {
    const int gw = blockIdx.x * NWAVES + wave, NGW = gridDim.x * NWAVES;
    bf16* Z = (bf16*)(p.ws + WS_Z);
    const int sub = lane & 7, head = lane >> 3;
    float gq[8], gk[8];
#pragma unroll
    for (int i = 0; i < 8; ++i) { gq[i] = p.q_norm_g[sub * 8 + i] * 0.125f; gk[i] = p.k_norm_g[sub * 8 + i]; }
    for (int m = gw; m < M_TOK; m += NGW) {
#pragma unroll
        for (int which = 0; which < 2; ++which) {
            u32x4* ptr = (u32x4*)(Z + (size_t)m * DINP + (which ? C_AK : C_AQ) + head * 64 + sub * 8);
            const u32x4 w = *ptr;
            float f[8] = {bflo(w.x), bfhi(w.x), bflo(w.y), bfhi(w.y), bflo(w.z), bfhi(w.z), bflo(w.w), bfhi(w.w)};
            float ss = 0.f;
#pragma unroll
            for (int i = 0; i < 8; ++i) ss += f[i] * f[i];
            ss += __shfl_xor(ss, 1); ss += __shfl_xor(ss, 2); ss += __shfl_xor(ss, 4);
            const float rstd = 1.0f / sqrtf(ss * (1.0f / 64.0f) + 1e-6f);
#pragma unroll
            for (int i = 0; i < 8; ++i) f[i] = f[i] * rstd * (which ? gk[i] : gq[i]);
            u32x4 o; o.x = pk2(f[0], f[1]); o.y = pk2(f[2], f[3]); o.z = pk2(f[4], f[5]); o.w = pk2(f[6], f[7]);
            *ptr = o;
        }
    }
}

__device__ __forceinline__ void na_phase_simple(const Params& p, int wave, int lane) {
    const int gw = blockIdx.x * NWAVES + wave, NGW = gridDim.x * NWAVES;
    const bf16* Z = (const bf16*)(p.ws + WS_Z);
    bf16* YAo = (bf16*)(p.ws + WS_YA);
    constexpr int NROWS = 2 * (T_PROMPT / 64) + 16 * (T_SAMPLE / 64);
    for (int item = gw; item < NROWS * NH; item += NGW) {
        const int head = item & 7, rowg = item >> 3;
        int seq, r, rows;
        if (rowg < 512) { seq = rowg >> 8; r = rowg & 255; rows = 256; } else { const int rr = rowg - 512; seq = 2 + (rr >> 6); r = rr & 63; rows = 64; }
        int start, len; seq_info(seq, start, len);
        const int mq = start + r * 64 + lane;
        u32x4 qv[8];
        { const u32x4* qp = (const u32x4*)(Z + (size_t)mq * DINP + C_AQ + head * 64);
#pragma unroll
          for (int i = 0; i < 8; ++i) qv[i] = qp[i]; }
        int kr0 = r - 4; kr0 = kr0 < 0 ? 0 : (kr0 > rows - 8 ? rows - 8 : kr0);
        int cs = lane - 8; cs = cs < 0 ? 0 : (cs > 48 ? 48 : cs);
        float o[64];
#pragma unroll
        for (int d = 0; d < 64; ++d) o[d] = 0.f;
        float mrun = -1e30f, lsum = 0.f;
        for (int kr = 0; kr < 8; ++kr) {
            const float* bias_row = p.rpb + ((size_t)head * 15 + (kr0 + kr - r + 7)) * 31 + (cs - lane + 15);
            const bf16* krow = Z + (size_t)(start + (kr0 + kr) * 64 + cs) * DINP + head * 64;
#pragma unroll 1
            for (int j = 0; j < 16; ++j) {
                const u32x4* kp = (const u32x4*)(krow + (size_t)j * DINP + C_AK);
                float s = 0.f;
#pragma unroll
                for (int i = 0; i < 8; ++i) { const u32x4 kv = kp[i];
                    s += bflo(qv[i].x) * bflo(kv.x) + bfhi(qv[i].x) * bfhi(kv.x) + bflo(qv[i].y) * bflo(kv.y) + bfhi(qv[i].y) * bfhi(kv.y)
                       + bflo(qv[i].z) * bflo(kv.z) + bfhi(qv[i].z) * bfhi(kv.z) + bflo(qv[i].w) * bflo(kv.w) + bfhi(qv[i].w) * bfhi(kv.w); }
                s += bias_row[j];
                const float mnew = fmaxf(mrun, s);
                const float alpha = __expf(mrun - mnew);
                const float pj = __expf(s - mnew);
                mrun = mnew;
                lsum = lsum * alpha + pj;
                const u32x4* vp = (const u32x4*)(krow + (size_t)j * DINP + C_AV);
#pragma unroll
                for (int i = 0; i < 8; ++i) { const u32x4 vv = vp[i];
                    o[8 * i + 0] = o[8 * i + 0] * alpha + pj * bflo(vv.x); o[8 * i + 1] = o[8 * i + 1] * alpha + pj * bfhi(vv.x);
                    o[8 * i + 2] = o[8 * i + 2] * alpha + pj * bflo(vv.y); o[8 * i + 3] = o[8 * i + 3] * alpha + pj * bfhi(vv.y);
                    o[8 * i + 4] = o[8 * i + 4] * alpha + pj * bflo(vv.z); o[8 * i + 5] = o[8 * i + 5] * alpha + pj * bfhi(vv.z);
                    o[8 * i + 6] = o[8 * i + 6] * alpha + pj * bflo(vv.w); o[8 * i + 7] = o[8 * i + 7] * alpha + pj * bfhi(vv.w); }
            }
        }
        const float inv = 1.0f / lsum;
        const u32x4* gp = (const u32x4*)(Z + (size_t)mq * DINP + C_AG + head * 64);
        u32x4* op = (u32x4*)(YAo + (size_t)mq * DRW + head * 64);
#pragma unroll
        for (int i = 0; i < 8; ++i) { const u32x4 gv = gp[i];
            const float g[8] = {bflo(gv.x), bfhi(gv.x), bflo(gv.y), bfhi(gv.y), bflo(gv.z), bfhi(gv.z), bflo(gv.w), bfhi(gv.w)};
            float r8[8];
#pragma unroll
            for (int e = 0; e < 8; ++e) r8[e] = o[8 * i + e] * inv * g[e] * sigmoidf_(g[e]);
            u32x4 w; w.x = pk2(r8[0], r8[1]); w.y = pk2(r8[2], r8[3]); w.z = pk2(r8[4], r8[5]); w.w = pk2(r8[6], r8[7]);
            op[i] = w; }
    }
}

constexpr int SB = 32;
constexpr int ZS_OFF = 0, ZS_BYTES = SB * 320 * 4;
constexpr int BUF_OFF = ZS_BYTES, BUF_BYTES = 6 * SB * 64 * 4;
static_assert(BUF_OFF + 2 * BUF_BYTES <= LDS_BYTES, "scan LDS");
__device__ __forceinline__ void scan_chain_simple(const Params& p, LAS unsigned char* lds, int z, int seq, int h, int wave, int lane) {
    const bf16* Z = (const bf16*)(p.ws + WS_Z);
    float* Y = p.out + (size_t)z * M_TOK * DRW;
    int start, T; seq_info(seq, start, T);
    const int nblk = T / SB;
    LAS float* zs = (LAS float*)(lds + ZS_OFF);
    float S[64];
#pragma unroll
    for (int k = 0; k < 64; ++k) S[k] = 0.f;
    const int hc = h * 64 + lane;
    const float w0c = p.w0[z * DRW + hc], a0c = p.a0[z * DRW + hc], kkc = p.k_k[hc], kac = p.k_a[hc];
    const float* wup = p.w_up + (size_t)z * 64 * DRW + hc;
    const float* aup = p.a_up + (size_t)z * 64 * DRW + hc;
    for (int nb = -1; nb < nblk; ++nb) {
        if (nb + 1 < nblk) {
            for (int e = threadIdx.x; e < SB * 320; e += NTHREADS) {
                const int tok = e / 320, col = e - tok * 320, seg = col >> 6, j = col & 63;
                const int zcol = seg < 3 ? (seg * 512 + h * 64 + j) : (C_WDN + (seg - 3) * 64 + j);
                const int pos = (nb + 1) * SB + tok, t = z ? (T - 1 - pos) : pos;
                const bf16* zp = Z + (size_t)(start + t) * DINP + zcol;
                const float u0 = bf2f(zp[0]);
                const float um = t > 0 ? bf2f(zp[-DINP]) : 0.f;
                const float up = t < T - 1 ? bf2f(zp[DINP]) : 0.f;
                float val = u0 + p.shift_mu[zcol] * (0.5f * (um + up) - u0);
                if (seg == 3) val = tanhf(val);
                zs[e] = val;
            }
        }
        __syncthreads();
        if (wave > 0) {
            if (nb + 1 < nblk) {
                LAS float* ob = (LAS float*)(lds + BUF_OFF + ((nb + 1) & 1) * BUF_BYTES);
                for (int tok = wave - 1; tok < SB; tok += 7) {
                    const LAS float* zr = zs + tok * 320;
                    float wl = 0.f, al = 0.f;
#pragma unroll 8
                    for (int l = 0; l < 64; ++l) { wl += zr[192 + l] * wup[(size_t)l * DRW]; al += zr[256 + l] * aup[(size_t)l * DRW]; }
                    const float xw = w0c + wl;
                    const float sp = fmaxf(-xw, 0.f) + log1pf(__expf(-fabsf(xw)));
                    const float decay = __expf(-__expf(-sp - 0.5f));
                    const float a = sigmoidf_(a0c + al);
                    const float r = zr[lane], k = zr[64 + lane], v = zr[128 + lane];
                    const float kkr = k * kkc;
                    const float nrm = sqrtf(wave_sum(kkr * kkr));
                    const float kk = kkr / fmaxf(nrm, 1e-12f);
                    ob[0 * SB * 64 + tok * 64 + lane] = r;
                    ob[1 * SB * 64 + tok * 64 + lane] = decay;
                    ob[2 * SB * 64 + tok * 64 + lane] = k * (1.0f + (a - 1.0f) * kac);
                    ob[3 * SB * 64 + tok * 64 + lane] = v;
                    ob[4 * SB * 64 + tok * 64 + lane] = kk;
                    ob[5 * SB * 64 + tok * 64 + lane] = kk * a;
                }
            }
        } else if (nb >= 0) {
            const LAS float* ib = (const LAS float*)(lds + BUF_OFF + (nb & 1) * BUF_BYTES);
            for (int tok = 0; tok < SB; ++tok) {
                const LAS f32x4* r4 = (const LAS f32x4*)(ib + 0 * SB * 64 + tok * 64);
                const LAS f32x4* w4 = (const LAS f32x4*)(ib + 1 * SB * 64 + tok * 64);
                const LAS f32x4* k4 = (const LAS f32x4*)(ib + 2 * SB * 64 + tok * 64);
                const LAS f32x4* kk4 = (const LAS f32x4*)(ib + 4 * SB * 64 + tok * 64);
                const LAS f32x4* ka4 = (const LAS f32x4*)(ib + 5 * SB * 64 + tok * 64);
                const float vi = ib[3 * SB * 64 + tok * 64 + lane];
                float skk0 = 0.f, skk1 = 0.f, skk2 = 0.f, skk3 = 0.f;
#pragma unroll
                for (int q = 0; q < 16; ++q) { const f32x4 c = kk4[q]; skk0 += S[4 * q] * c.x; skk1 += S[4 * q + 1] * c.y; skk2 += S[4 * q + 2] * c.z; skk3 += S[4 * q + 3] * c.w; }
                const float nskk = -((skk0 + skk1) + (skk2 + skk3));
                float y0 = 0.f, y1 = 0.f, y2 = 0.f, y3 = 0.f;
#pragma unroll
                for (int q = 0; q < 16; ++q) { const f32x4 wv = w4[q], kv = k4[q], av = ka4[q], rv = r4[q];
                    S[4 * q + 0] = S[4 * q + 0] * wv.x + (vi * kv.x + nskk * av.x); y0 += S[4 * q + 0] * rv.x;
                    S[4 * q + 1] = S[4 * q + 1] * wv.y + (vi * kv.y + nskk * av.y); y1 += S[4 * q + 1] * rv.y;
                    S[4 * q + 2] = S[4 * q + 2] * wv.z + (vi * kv.z + nskk * av.z); y2 += S[4 * q + 2] * rv.z;
                    S[4 * q + 3] = S[4 * q + 3] * wv.w + (vi * kv.w + nskk * av.w); y3 += S[4 * q + 3] * rv.w; }
                const int pos = nb * SB + tok, t = z ? (T - 1 - pos) : pos;
                Y[(size_t)(start + t) * DRW + hc] = (y0 + y1) + (y2 + y3);
            }
        }
        __syncthreads();
    }
}
__device__ __forceinline__ void scan_phase_simple(const Params& p, LAS unsigned char* lds, int wave, int lane) {
    const int b = blockIdx.x;
    if (b < 32) { scan_chain_simple(p, lds, b & 1, b >> 4, (b >> 1) & 7, wave, lane); }
    else {
        for (int q = b - 32; q < 256; q += (int)gridDim.x - 32) scan_chain_simple(p, lds, q & 1, 2 + (q >> 4), (q >> 1) & 7, wave, lane);
    }
}

__device__ __forceinline__ void mix_phase(const Params& p, LAS unsigned char* lds, int wave, int lane) {
    const bf16* Z = (const bf16*)(p.ws + WS_Z);
    bf16* MX = (bf16*)(p.ws + WS_MIXED);
    const float* Yf = p.out; const float* Yb = p.out + (size_t)M_TOK * DRW;
    LAS float* adn = (LAS float*)lds;
    const int c = threadIdx.x;
    float au0[64], au1[64];
#pragma unroll
    for (int l = 0; l < 64; ++l) { au0[l] = p.a_up[(size_t)l * DRW + c]; au1[l] = p.a_up[(size_t)(64 + l) * DRW + c]; }
    const float mu_r = p.shift_mu[C_R + c], mu_k = p.shift_mu[C_K + c], mu_v = p.shift_mu[C_V + c], mu_g = p.shift_mu[C_G + c];
    const float a00 = p.a0[c], a01 = p.a0[DRW + c], kac = p.k_a[c], rkc = p.r_k[c], lg = p.lnx_g[c], lb = p.lnx_b[c];
    const int tk_s = threadIdx.x >> 6, l_s = threadIdx.x & 63;
    const float mu_a = p.shift_mu[C_ADN + l_s];
    for (int g = blockIdx.x; g < M_TOK / 8; g += gridDim.x) {
        { const int m = g * 8 + tk_s; int t, T; seq_of_token(m, t, T);
          const bf16* zp = Z + (size_t)m * DINP + C_ADN + l_s;
          const float u0 = bf2f(zp[0]), um = t > 0 ? bf2f(zp[-DINP]) : 0.f, up = t < T - 1 ? bf2f(zp[DINP]) : 0.f;
          adn[tk_s * 64 + l_s] = u0 + mu_a * (0.5f * (um + up) - u0); }
        __syncthreads();
        for (int tk = 0; tk < 8; ++tk) {
            const int m = g * 8 + tk; int t, T; seq_of_token(m, t, T);
            const bf16* zp = Z + (size_t)m * DINP + c;
            const bool hp = t > 0, hn = t < T - 1;
            float r0 = bf2f(zp[C_R]), k0 = bf2f(zp[C_K]), v0 = bf2f(zp[C_V]), g0 = bf2f(zp[C_G]);
            float rm = hp ? bf2f(zp[C_R - DINP]) : 0.f, km = hp ? bf2f(zp[C_K - DINP]) : 0.f, vm = hp ? bf2f(zp[C_V - DINP]) : 0.f, gm = hp ? bf2f(zp[C_G - DINP]) : 0.f;
            float rp = hn ? bf2f(zp[C_R + DINP]) : 0.f, kp = hn ? bf2f(zp[C_K + DINP]) : 0.f, vp = hn ? bf2f(zp[C_V + DINP]) : 0.f, gp = hn ? bf2f(zp[C_G + DINP]) : 0.f;
            const float r = r0 + mu_r * (0.5f * (rm + rp) - r0), k = k0 + mu_k * (0.5f * (km + kp) - k0);
            const float v = v0 + mu_v * (0.5f * (vm + vp) - v0), gt = g0 + mu_g * (0.5f * (gm + gp) - g0);
            float al0 = a00, al1 = a01;
            const LAS f32x4* ad4 = (const LAS f32x4*)(adn + tk * 64);
#pragma unroll
            for (int q = 0; q < 16; ++q) { const f32x4 a4 = ad4[q];
                al0 += a4.x * au0[4 * q] + a4.y * au0[4 * q + 1] + a4.z * au0[4 * q + 2] + a4.w * au0[4 * q + 3];
                al1 += a4.x * au1[4 * q] + a4.y * au1[4 * q + 1] + a4.z * au1[4 * q + 2] + a4.w * au1[4 * q + 3]; }
            const float as = sigmoidf_(al0) + sigmoidf_(al1);
            const float ksum = k * (2.0f + (as - 2.0f) * kac);
            const float bonus = wave_sum(r * rkc * ksum);
            const float y = Yf[(size_t)m * DRW + c] + Yb[(size_t)m * DRW + c];
            const float mean = wave_sum(y) * (1.0f / 64.0f);
            const float d = y - mean;
            const float var = wave_sum(d * d) * (1.0f / 64.0f);
            const float yn = d * (1.0f / sqrtf(var + 64e-5f)) * lg + lb;
            const float res = (yn + bonus * v) * gt * sigmoidf_(gt);
            MX[(size_t)m * DM + c] = (bf16)f2bf(res);
        }
        __syncthreads();
    }
}

typedef short bf16x8 __attribute__((ext_vector_type(8)));
typedef short s16x4 __attribute__((ext_vector_type(4)));
typedef float f32x16 __attribute__((ext_vector_type(16)));
typedef float f32x2v __attribute__((ext_vector_type(2)));
typedef __bf16 bf16x2_t __attribute__((ext_vector_type(2)));
#define MFMA32(a, b, c) __builtin_amdgcn_mfma_f32_32x32x16_bf16((a), (b), (c), 0, 0, 0)
#define MFMA16(a, b, c) __builtin_amdgcn_mfma_f32_16x16x32_bf16((a), (b), (c), 0, 0, 0)
__device__ __forceinline__ unsigned cvt2(float lo, float hi) { f32x2v v = {lo, hi}; return __builtin_bit_cast(unsigned, __builtin_convertvector(v, bf16x2_t)); }
__device__ __forceinline__ bf16x8 mk8(unsigned a, unsigned b, unsigned c, unsigned d) { u32x4 v = {a, b, c, d}; return __builtin_bit_cast(bf16x8, v); }
__device__ __forceinline__ bf16x8 neg8(bf16x8 x) { u32x4 v = __builtin_bit_cast(u32x4, x); v.x ^= 0x80008000u; v.y ^= 0x80008000u; v.z ^= 0x80008000u; v.w ^= 0x80008000u; return __builtin_bit_cast(bf16x8, v); }
__device__ __forceinline__ bf16x8 pack32(const f32x16& x, int s) {
    return mk8(cvt2(x[8 * s + 0], x[8 * s + 1]), cvt2(x[8 * s + 2], x[8 * s + 3]), cvt2(x[8 * s + 4], x[8 * s + 5]), cvt2(x[8 * s + 6], x[8 * s + 7]));
}
__device__ __forceinline__ unsigned sw_addr(unsigned base, int row, int kbyte) { return base + row * 128 + ((((kbyte >> 4) ^ (row >> 1)) & 7) << 4) + (kbyte & 15); }
struct LdsA {
    unsigned v32;
    unsigned vp;
    unsigned v16;
    unsigned vc;
    unsigned vt;
    unsigned raw;
};
__device__ __forceinline__ LdsA make_ldsa(unsigned grp_base, int w, int lane) {
    LdsA a; const int l31 = lane & 31, hh = lane >> 5, sw = (l31 >> 1) & 7, l15 = lane & 15, tq = lane >> 4, sw16 = l15 >> 1;
    a.raw = grp_base;
    a.v32 = grp_base + l31 * 128 + ((hh ^ sw) << 4);
    a.vp = grp_base + l31 * 128 + (sw << 4) + 8 * hh;
    a.v16 = grp_base + l15 * 128 + ((tq ^ sw16) << 4);
    const int c = 16 * w + l15;
    a.vc = grp_base + c * 128 + (((tq >> 1) ^ ((l15 >> 1) & 7)) << 4) + 8 * (tq & 1);
    a.vt = grp_base + 512 * tq + ((((2 * w + (l15 >> 3)) ^ (2 * tq)) & 7) << 4) + 2 * (l15 & 7);
    return a;
}
__device__ __forceinline__ LAS unsigned char* ldsptr(unsigned a) { return (LAS unsigned char*)(size_t)a; }
__device__ __forceinline__ bf16x8 ld_frag32(const LdsA& A, unsigned slot, int row0, int k0) {
    return *(const LAS bf16x8*)ldsptr((A.v32 ^ (unsigned)(k0 * 2)) + slot + row0 * 128);
}
__device__ __forceinline__ bf16x8 ld_frag32p(const LdsA& A, unsigned slot, int row0, int k0) {
    const u32x2 a = *(const LAS u32x2*)ldsptr((A.vp ^ (unsigned)(k0 * 2)) + slot + row0 * 128);
    const u32x2 b = *(const LAS u32x2*)ldsptr((A.vp ^ (unsigned)(k0 * 2 + 16)) + slot + row0 * 128);
    return mk8(a.x, a.y, b.x, b.y);
}
__device__ __forceinline__ bf16x8 ld_frag16(const LdsA& A, unsigned slot, int row0, int k0) {
    return *(const LAS bf16x8*)ldsptr((A.v16 ^ (unsigned)(k0 * 2)) + slot + row0 * 128);
}
__device__ __forceinline__ void write_c(const LdsA& A, unsigned slot, const f32x16& acc, int row_off, int col_off) {
#pragma unroll
    for (int g = 0; g < 4; ++g) {
        u32x2 v; v.x = cvt2(acc[4 * g], acc[4 * g + 1]); v.y = cvt2(acc[4 * g + 2], acc[4 * g + 3]);
        *(LAS u32x2*)ldsptr((A.vp ^ (unsigned)((row_off / 8 + g) << 4)) + slot + col_off * 128) = v;
    }
}
__device__ __forceinline__ int crow32(int reg, int hh) { return (reg & 3) + 8 * (reg >> 2) + 4 * hh; }
__device__ __forceinline__ int pi_perm(int c) { return (c & 32) + 8 * ((c >> 2) & 3) + 4 * ((c >> 4) & 1) + (c & 3); }

constexpr int GRP_BYTES = 77824;
constexpr unsigned SL_QTT = 0, SL_BCT = 8192, SL_KCT = 16384, SL_RTT = 24576, SL_QTC = 32768, SL_TR = 40960, SL_BHC = 49152, SL_KHC = 57344, SL_VC = 65536;
constexpr unsigned SL_LKR = SL_QTT, SL_MKR = SL_BCT, SL_MBR = SL_KCT;
constexpr unsigned SL_LW = 49152, SL_LA = 57344, RAW_OFF = 0, RAW_STRIDE = 656;
constexpr unsigned EX_RN = 73728, EX_GC = EX_RN + 256, EX_BON = EX_GC + 256;
static_assert(RAW_OFF + 66 * RAW_STRIDE <= SL_LW && SL_VC + 8192 <= EX_RN && EX_BON + 1024 + 16 <= GRP_BYTES && 2 * GRP_BYTES <= LDS_BYTES - 16, "rwkv LDS map");
constexpr int NGCHUNK = M_TOK / 64;

__device__ __forceinline__ void neumann32(const LdsA& A, int blk, int lane, f32x16& T, f32x16& TT) {
    const int r0 = 32 * blk, hh = lane >> 5, col = lane & 31;
    f32x16 X, XT;
#pragma unroll
    for (int i = 0; i < 16; ++i) { X[i] = 0.f; XT[i] = 0.f; }
#pragma unroll
    for (int kk = 0; kk < 4; ++kk) {
        const bf16x8 fq = ld_frag32(A, SL_QTT, r0, 16 * kk), fb = ld_frag32(A, SL_BCT, r0, 16 * kk);
        X = MFMA32(fq, fb, X); XT = MFMA32(fb, fq, XT);
    }
#pragma unroll
    for (int reg = 0; reg < 16; ++reg) {
        const int row = crow32(reg, hh);
        X[reg] = (col < row) ? X[reg] : 0.f; XT[reg] = (row < col) ? XT[reg] : 0.f;
        const float id = (row == col) ? 1.f : 0.f;
        T[reg] = id - X[reg]; TT[reg] = id - XT[reg];
    }
#pragma unroll
    for (int rnd = 0; rnd < 4; ++rnd) {
        f32x16 X2, XT2;
#pragma unroll
        for (int i = 0; i < 16; ++i) { X2[i] = 0.f; XT2[i] = 0.f; }
#pragma unroll
        for (int s = 0; s < 2; ++s) { const bf16x8 px = pack32(X, s), pxt = pack32(XT, s); X2 = MFMA32(pxt, px, X2); XT2 = MFMA32(px, pxt, XT2); }
        X = X2; XT = XT2;
        { const bf16x8 pxt0 = pack32(XT, 0), pxt1 = pack32(XT, 1), pt0 = pack32(T, 0), pt1 = pack32(T, 1);
          T = MFMA32(pxt0, pt0, T); T = MFMA32(pxt1, pt1, T); TT = MFMA32(pt0, pxt0, TT); TT = MFMA32(pt1, pxt1, TT); }
    }
}
__device__ __forceinline__ f32x16 score_t(const LdsA& A, unsigned slotY, unsigned slotX, int J, int I, bool strict, int lane) {
    f32x16 acc;
#pragma unroll
    for (int i = 0; i < 16; ++i) acc[i] = 0.f;
#pragma unroll
    for (int kk = 0; kk < 4; ++kk) acc = MFMA32(ld_frag32(A, slotY, 32 * J, 16 * kk), ld_frag32(A, slotX, 32 * I, 16 * kk), acc);
    if (J == I) {
        const int hh = lane >> 5, icol = lane & 31;
#pragma unroll
        for (int reg = 0; reg < 16; ++reg) { const int jrow = crow32(reg, hh); const bool keep = strict ? (jrow < icol) : (jrow <= icol); acc[reg] = keep ? acc[reg] : 0.f; }
    }
    return acc;
}

__device__ __forceinline__ void lora_prep_phase(const Params& p) {
    const bf16* Z = (const bf16*)(p.ws + WS_Z); bf16* LD = (bf16*)(p.ws + WS_LD);
    const int gtid = (int)blockIdx.x * NTHREADS + (int)threadIdx.x, NT = (int)gridDim.x * NTHREADS;
    const int c16 = gtid & 15;
    const f32x4 mu0 = *(const f32x4*)(p.shift_mu + C_WDN + c16 * 8), mu1 = *(const f32x4*)(p.shift_mu + C_WDN + c16 * 8 + 4);
    const float mu[8] = {mu0.x, mu0.y, mu0.z, mu0.w, mu1.x, mu1.y, mu1.z, mu1.w};
    constexpr int LB = 6;
    for (int idx0 = gtid; idx0 < M_TOK * 16; idx0 += LB * NT) {
        u32x4 u0[LB], um[LB], up[LB]; bool vm_[LB], vp_[LB];
#pragma unroll
        for (int r = 0; r < LB; ++r) { const int idx = idx0 + r * NT, m = (idx < M_TOK * 16 ? idx : gtid) >> 4; int tp, T; seq_of_token(m, tp, T);
            const bf16* zp = ZS(Z, m, C_WDN + c16 * 8); vm_[r] = tp > 0; vp_[r] = tp < T - 1;
            u0[r] = *(const u32x4*)zp; um[r] = *(const u32x4*)(zp - (vm_[r] ? ZW : 0)); up[r] = *(const u32x4*)(zp + (vp_[r] ? ZW : 0)); }
#pragma unroll
        for (int r = 0; r < LB; ++r) { const int idx = idx0 + r * NT;
            const u32x4 z4 = {0u, 0u, 0u, 0u}; const u32x4 a = u0[r], bm = vm_[r] ? um[r] : z4, bp = vp_[r] ? up[r] : z4;
            const float a0_[8] = {bflo(a.x), bfhi(a.x), bflo(a.y), bfhi(a.y), bflo(a.z), bfhi(a.z), bflo(a.w), bfhi(a.w)};
            const float am[8] = {bflo(bm.x), bfhi(bm.x), bflo(bm.y), bfhi(bm.y), bflo(bm.z), bfhi(bm.z), bflo(bm.w), bfhi(bm.w)};
            const float ap[8] = {bflo(bp.x), bfhi(bp.x), bflo(bp.y), bfhi(bp.y), bflo(bp.z), bfhi(bp.z), bflo(bp.w), bfhi(bp.w)};
            float val[8];
#pragma unroll
            for (int e = 0; e < 8; ++e) val[e] = a0_[e] + mu[e] * (0.5f * (am[e] + ap[e]) - a0_[e]);
            if (c16 < 8) {
#pragma unroll
                for (int e = 0; e < 8; ++e) val[e] = 1.0f - 2.0f / (1.0f + __expf(2.0f * val[e]));
            }
            u32x4 o; o.x = cvt2(val[0], val[1]); o.y = cvt2(val[2], val[3]); o.z = cvt2(val[4], val[5]); o.w = cvt2(val[6], val[7]);
            if (idx < M_TOK * 16) *(u32x4*)(LD + (size_t)(idx >> 4) * 128 + c16 * 8) = o; }
    }
    float* RN = (float*)(p.ws + WS_RN);
    const int ch = gtid & 7, h = (gtid >> 3) & 7;
    const f32x4 m0_ = *(const f32x4*)(p.shift_mu + C_K + h * 64 + ch * 8), m1_ = *(const f32x4*)(p.shift_mu + C_K + h * 64 + ch * 8 + 4);
    const f32x4 k0 = *(const f32x4*)(p.k_k + h * 64 + ch * 8), k1 = *(const f32x4*)(p.k_k + h * 64 + ch * 8 + 4);
    const float muk[8] = {m0_.x, m0_.y, m0_.z, m0_.w, m1_.x, m1_.y, m1_.z, m1_.w}, kkv[8] = {k0.x, k0.y, k0.z, k0.w, k1.x, k1.y, k1.z, k1.w};
    const int mstep = NT >> 6;
    for (int mb = gtid >> 6; mb < M_TOK; mb += 8 * mstep) {
        u32x4 u0[8], um[8], up[8];
#pragma unroll
        for (int r = 0; r < 8; ++r) { const int m_ = mb + r * mstep, m = m_ < M_TOK ? m_ : mb; int tp, T; seq_of_token(m, tp, T);
            const bf16* zp = ZS(Z, m, C_K + h * 64 + ch * 8); const bool vm_ = tp > 0, vp_ = tp < T - 1; const u32x4 z4 = {0u, 0u, 0u, 0u};
            u0[r] = *(const u32x4*)zp; const u32x4 xm = *(const u32x4*)(zp - (vm_ ? ZW : 0)), xp = *(const u32x4*)(zp + (vp_ ? ZW : 0));
            um[r] = vm_ ? xm : z4; up[r] = vp_ ? xp : z4; }
#pragma unroll
        for (int r = 0; r < 8; ++r) { const int m = mb + r * mstep;
            const float a0_[8] = {bflo(u0[r].x), bfhi(u0[r].x), bflo(u0[r].y), bfhi(u0[r].y), bflo(u0[r].z), bfhi(u0[r].z), bflo(u0[r].w), bfhi(u0[r].w)};
            const float am[8] = {bflo(um[r].x), bfhi(um[r].x), bflo(um[r].y), bfhi(um[r].y), bflo(um[r].z), bfhi(um[r].z), bflo(um[r].w), bfhi(um[r].w)};
            const float ap[8] = {bflo(up[r].x), bfhi(up[r].x), bflo(up[r].y), bfhi(up[r].y), bflo(up[r].z), bfhi(up[r].z), bflo(up[r].w), bfhi(up[r].w)};
            float ss = 0.f;
#pragma unroll
            for (int e = 0; e < 8; ++e) { const float v_ = a0_[e] + muk[e] * (0.5f * (am[e] + ap[e]) - a0_[e]); const float q = v_ * kkv[e]; ss += q * q; }
            ss = dpp_sum8(ss);
            if (ch == 0 && m < M_TOK) RN[(size_t)m * NH + h] = __builtin_amdgcn_rsqf(fmaxf(ss, 1e-24f)); }
    }
}
#define LDS_BAR() do { asm volatile("s_waitcnt lgkmcnt(0)" ::: "memory"); \
        if (lane_in == 0) __hip_atomic_fetch_add(grp_cnt, 1u, __ATOMIC_RELAXED, __HIP_MEMORY_SCOPE_WORKGROUP); \
        grp_epoch += 4u; \
        while ((unsigned)__builtin_amdgcn_readfirstlane(__hip_atomic_load(grp_cnt, __ATOMIC_RELAXED, __HIP_MEMORY_SCOPE_WORKGROUP)) < grp_epoch) __builtin_amdgcn_s_sleep(1); \
        asm volatile("s_waitcnt lgkmcnt(0)" ::: "memory"); } while (0)
__device__ __forceinline__ void rwkv_pre_phase(const Params& p, LAS unsigned char* lds_wg, int wave, int lane_in) {
    const int grp = wave >> 2, w = wave & 3, z = grp;
    LAS unsigned char* lds = lds_wg + grp * GRP_BYTES;
    const int gt = threadIdx.x & 255;
    LdsA A = make_ldsa((unsigned)(size_t)lds, w, lane_in);
    const bf16* Z = (const bf16*)(p.ws + WS_Z);
    const bf16* wupT = (const bf16*)(p.ws + WS_WUPT); const bf16* aupT = (const bf16*)(p.ws + WS_AUPT);
    LAS float* ex_rn = (LAS float*)(lds + EX_RN); LAS float* ex_gc = (LAS float*)(lds + EX_GC); LAS float* ex_bon = (LAS float*)(lds + EX_BON);
    LAS unsigned* grp_cnt = (LAS unsigned*)(lds + EX_BON + 1024); unsigned grp_epoch = 0u;
    if (gt == 0) *grp_cnt = 0u;
    __syncthreads();
    LAS float* ctab = (LAS float*)(lds_wg + 2 * GRP_BYTES + grp * 4080); int ctab_h = -1;
    const bf16* LD = (const bf16*)(p.ws + WS_LD); const float* RNp = (const float*)(p.ws + WS_RN);
    u32x4 pf[11];
    const int pre_rg = gt / 24, pre_chunk = gt - pre_rg * 24, pre_sg = pre_chunk >> 3, pre_ch = pre_chunk & 7; const bool pre_act = gt < 240;
#define PRE_ISSUE(item_, valid_) do { const int h_ = (item_) & 7, m0_ = ((item_) >> 3) * 64; int tp0_, T_; seq_of_token(m0_, tp0_, T_); \
        const bf16* src_ = ZS(Z, m0_ + pre_rg, pre_sg * 512 + h_ * 64 + pre_ch * 8);     \
        _Pragma("unroll") for (int it = 0; it < 7; ++it) { \
            const int rr_ = 10 * it + pre_rg, tp = tp0_ - 1 + rr_; \
            pf[it] = (u32x4){0u, 0u, 0u, 0u}; \
            if ((valid_) && pre_act && rr_ < 66 && tp >= 0 && tp < T_) pf[it] = *(const u32x4*)(src_ + (10 * it - 1) * ZW); \
            if ((valid_) && !pre_act && it < 4) { const int jr_ = (gt - 240) * 4 + it; pf[it].x = __float_as_uint(RNp[(size_t)(m0_ + (z ? 63 - jr_ : jr_)) * NH + h_]); } } \
        _Pragma("unroll") for (int q_ = 0; q_ < 4; ++q_) { \
            const int task_ = q_ * 256 + gt, j_ = task_ >> 4, tl_ = z ? 63 - j_ : j_; \
            pf[7 + q_] = (u32x4){0u, 0u, 0u, 0u}; \
            if (valid_) pf[7 + q_] = *(const u32x4*)(LD + (size_t)(m0_ + tl_) * 128 + (task_ & 15) * 8); } } while (0)
    const int nitems = (NGCHUNK * NH - (int)blockIdx.x + (int)gridDim.x - 1) / (int)gridDim.x;
    PRE_ISSUE((int)blockIdx.x, nitems > 0);
    for (int it_ = 0; it_ < nitems; ++it_) {
        const int item = (int)blockIdx.x + it_ * (int)gridDim.x;
        asm volatile("" : "+v"(A.v32), "+v"(A.vp), "+v"(A.v16), "+v"(A.vc), "+v"(A.vt));
        int lane_o = lane_in; asm volatile("" : "+v"(lane_o));
        const int lane = lane_o, cl_ = lane & 15, tq = lane >> 4, hh = lane >> 5;
        const int h = item & 7, gchunk = item >> 3;
        const int m0 = gchunk * 64;
        int tpos0, T; seq_of_token(m0, tpos0, T);
        if (h != ctab_h) {
            ctab[gt] = gt < 128 ? p.shift_mu[C_WDN + gt] : (gt < 192 ? p.shift_mu[C_K + h * 64 + gt - 128] : p.k_k[h * 64 + gt - 192]);
            ctab[256 + gt] = gt < 64 ? p.shift_mu[C_R + h * 64 + gt] : (gt < 128 ? p.shift_mu[C_V + h * 64 + gt - 64] : -1.4426950408889634f * (gt < 192 ? p.w0[z * DRW + h * 64 + gt - 128] : p.a0[z * DRW + h * 64 + gt - 192]));
            if (gt < 128) ctab[512 + gt] = gt < 64 ? p.k_a[h * 64 + gt] : p.r_k[h * 64 + gt - 64];
            ctab_h = h;
        }
        const int c = 16 * w + cl_, hc = h * 64 + c;
        bf16x8 bw[2], ba[2];
#pragma unroll
        for (int s = 0; s < 2; ++s) {
            bw[s] = *(const bf16x8*)(wupT + ((size_t)(z * DRW + hc) * 64 + 32 * s + 8 * tq));
            ba[s] = *(const bf16x8*)(aupT + ((size_t)(z * DRW + hc) * 64 + 32 * s + 8 * tq));
        }
        {
        {
            if (pre_act) {
                LAS unsigned char* dst_ = lds + RAW_OFF + pre_rg * RAW_STRIDE + pre_chunk * 16;
#pragma unroll
                for (int it = 0; it < 7; ++it) if (10 * it + pre_rg < 66) *(LAS u32x4*)(dst_ + it * (10 * RAW_STRIDE)) = pf[it];
            }
            if (!pre_act) {
#pragma unroll
                for (int it = 0; it < 4; ++it) ex_rn[(gt - 240) * 4 + it] = __uint_as_float(pf[it].x);
            }
#pragma unroll
            for (int q_ = 0; q_ < 4; ++q_) { const int task_ = q_ * 256 + gt, j_ = task_ >> 4, c16_ = task_ & 15;
                *(LAS u32x4*)(lds + sw_addr((c16_ >> 3) ? SL_LA : SL_LW, j_, (c16_ & 7) * 16)) = pf[7 + q_]; }
        }
        LDS_BAR();
        f32x4 accw[4], acca[4];
        {
            const float w0s = ctab[384 + c], a0s = ctab[448 + c];
#pragma unroll
            for (int tt = 0; tt < 4; ++tt) {
                accw[tt] = (f32x4){w0s, w0s, w0s, w0s}; acca[tt] = (f32x4){a0s, a0s, a0s, a0s};
#pragma unroll
                for (int s = 0; s < 2; ++s) {
                    accw[tt] = MFMA16(ld_frag16(A, SL_LW, 16 * tt, 32 * s), bw[s], accw[tt]);
                    acca[tt] = MFMA16(ld_frag16(A, SL_LA, 16 * tt, 32 * s), ba[s], acca[tt]);
                }
            }
        }
        float er[4][4], ek[4][4];
        {
            const float mur = ctab[256 + c], muk = ctab[128 + c], muv = ctab[320 + c];
#pragma unroll
            for (int tt = 0; tt < 4; ++tt) {
                const int jb = 16 * tt + 4 * tq, tl0 = z ? 60 - jb : jb;
                const LAS unsigned short* rw_ = (const LAS unsigned short*)(lds + RAW_OFF + tl0 * RAW_STRIDE) + c;
                float ur[6], uk[6], uv[6];
#pragma unroll
                for (int a_ = 0; a_ < 6; ++a_) { ur[a_] = bf2f(rw_[a_ * (RAW_STRIDE / 2)]); uk[a_] = bf2f(rw_[a_ * (RAW_STRIDE / 2) + 64]); uv[a_] = bf2f(rw_[a_ * (RAW_STRIDE / 2) + 128]); }
                float ev[4];
#pragma unroll
                for (int a_ = 0; a_ < 4; ++a_) {
                    const int r_ = z ? 3 - a_ : a_;
                    er[tt][r_] = ur[a_ + 1] + mur * (0.5f * (ur[a_] + ur[a_ + 2]) - ur[a_ + 1]);
                    ek[tt][r_] = uk[a_ + 1] + muk * (0.5f * (uk[a_] + uk[a_ + 2]) - uk[a_ + 1]);
                    ev[r_] = uv[a_ + 1] + muv * (0.5f * (uv[a_] + uv[a_ + 2]) - uv[a_ + 1]);
                }
                { u32x2 v_; v_.x = cvt2(ev[0], ev[1]); v_.y = cvt2(ev[2], ev[3]); *(LAS u32x2*)ldsptr((A.vc ^ (unsigned)(32 * tt)) + SL_VC) = v_; }
            }
        }
        LDS_BAR();
        const float kkc = ctab[192 + c], kac = ctab[512 + c], rkc = ctab[576 + c];
        f32x4 lw[4], av[4];
#pragma unroll
        for (int tt = 0; tt < 4; ++tt)
#pragma unroll
            for (int r_ = 0; r_ < 4; ++r_) { lw[tt][r_] = -0.87503878f * __builtin_amdgcn_rcpf(1.0f + __builtin_amdgcn_exp2f(accw[tt][r_])); av[tt][r_] = __builtin_amdgcn_rcpf(1.0f + __builtin_amdgcn_exp2f(acca[tt][r_])); }
        f32x4 cl4[4];
        {
            bf16x8 bhi[2], blo[2];
#pragma unroll
            for (int s = 0; s < 2; ++s) {
                float lo_[8]; unsigned hi_u[4];
#pragma unroll
                for (int e = 0; e < 8; e += 2) {
                    const float x0 = lw[2 * s + (e >> 2)][e & 3], x1 = lw[2 * s + (e >> 2)][(e & 3) + 1];
                    const unsigned hw = cvt2(x0, x1); hi_u[e >> 1] = hw;
                    lo_[e] = x0 - bflo(hw); lo_[e + 1] = x1 - bfhi(hw);
                }
                bhi[s] = mk8(hi_u[0], hi_u[1], hi_u[2], hi_u[3]);
                blo[s] = mk8(cvt2(lo_[0], lo_[1]), cvt2(lo_[2], lo_[3]), cvt2(lo_[4], lo_[5]), cvt2(lo_[6], lo_[7]));
            }
            const unsigned M0 = ((4 * tq + 0 <= cl_) ? 0x3F80u : 0u) | ((4 * tq + 1 <= cl_) ? 0x3F800000u : 0u), M1 = ((4 * tq + 2 <= cl_) ? 0x3F80u : 0u) | ((4 * tq + 3 <= cl_) ? 0x3F800000u : 0u);
            const unsigned ON = 0x3F803F80u;
            const bf16x8 TA = mk8(M0, M1, 0u, 0u), TB = mk8(ON, ON, M0, M1), T1 = mk8(ON, ON, ON, ON);
            const f32x4 z4 = {0.f, 0.f, 0.f, 0.f};
            cl4[0] = MFMA16(TA, bhi[0], z4); cl4[0] = MFMA16(TA, blo[0], cl4[0]);
            cl4[1] = MFMA16(TB, bhi[0], z4); cl4[1] = MFMA16(TB, blo[0], cl4[1]);
            cl4[2] = MFMA16(T1, bhi[0], z4); cl4[2] = MFMA16(T1, blo[0], cl4[2]); cl4[2] = MFMA16(TA, bhi[1], cl4[2]); cl4[2] = MFMA16(TA, blo[1], cl4[2]);
            cl4[3] = MFMA16(T1, bhi[0], z4); cl4[3] = MFMA16(T1, blo[0], cl4[3]); cl4[3] = MFMA16(TB, bhi[1], cl4[3]); cl4[3] = MFMA16(TB, blo[1], cl4[3]);
        }
        float clast;
        { const auto r32_ = __builtin_amdgcn_permlane32_swap(__float_as_uint(cl4[3][3]), __float_as_uint(cl4[3][3]), false, false);
          const auto r16_ = __builtin_amdgcn_permlane16_swap(r32_[1], r32_[1], false, false); clast = __uint_as_float(r16_[1]); }
        const float gC_ = __builtin_amdgcn_exp2f(clast);
#pragma unroll
        for (int tt = 0; tt < 4; ++tt) {
            float qt[4], rt[4], bc[4], kc[4], kh[4], bh[4], bon[4];
            float g_prev = __builtin_amdgcn_exp2f(cl4[tt][0] - lw[tt][0]);
#pragma unroll
            for (int r_ = 0; r_ < 4; ++r_) {
                const float clv = cl4[tt][r_], a_ = av[tt][r_];
                const float g_in = __builtin_amdgcn_exp2f(clv), g_ex = g_prev, g_inv = __builtin_amdgcn_exp2f(-clv), g_end = gC_ * g_inv;
                g_prev = g_in;
                const float k_ = ek[tt][r_];
                const float kk_ = k_ * kkc * ex_rn[16 * tt + 4 * tq + r_], kd_ = k_ * (1.0f + (a_ - 1.0f) * kac), kka_ = kk_ * a_;
                qt[r_] = kk_ * g_ex; rt[r_] = er[tt][r_] * g_in; bc[r_] = kka_ * g_inv; kc[r_] = kd_ * g_inv; kh[r_] = kd_ * g_end; bh[r_] = kka_ * g_end;
                bon[r_] = er[tt][r_] * rkc * kd_;
            }
#define CMW(slot, lo, hi) do { u32x2 v_; v_.x = (lo); v_.y = (hi); *(LAS u32x2*)ldsptr((A.vc ^ (unsigned)(32 * tt)) + (slot)) = v_; } while (0)
#define TMW(slot, lo, hi) do { const unsigned a_ = (lo), b_ = (hi); \
                *(LAS unsigned short*)ldsptr(A.vt + (slot) + 2048 * tt + 0) = (unsigned short)(a_ & 0xffffu); *(LAS unsigned short*)ldsptr(A.vt + (slot) + 2048 * tt + 128) = (unsigned short)(a_ >> 16); \
                *(LAS unsigned short*)ldsptr((A.vt ^ 16u) + (slot) + 2048 * tt + 256) = (unsigned short)(b_ & 0xffffu); *(LAS unsigned short*)ldsptr((A.vt ^ 16u) + (slot) + 2048 * tt + 384) = (unsigned short)(b_ >> 16); } while (0)
            { const unsigned q0 = cvt2(qt[0], qt[1]), q1 = cvt2(qt[2], qt[3]); CMW(SL_QTC, q0, q1); TMW(SL_QTT, q0, q1); }
            CMW(SL_BHC, cvt2(bh[0], bh[1]), cvt2(bh[2], bh[3]));
            CMW(SL_KHC, cvt2(kh[0], kh[1]), cvt2(kh[2], kh[3]));
            TMW(SL_RTT, cvt2(rt[0], rt[1]), cvt2(rt[2], rt[3]));
            TMW(SL_BCT, cvt2(bc[0], bc[1]), cvt2(bc[2], bc[3]));
            TMW(SL_KCT, cvt2(kc[0], kc[1]), cvt2(kc[2], kc[3]));
            { const float s_ = dpp_rs16x4(bon[0], bon[1], bon[2], bon[3], cl_);
              if (cl_ < 4) ex_bon[w * 64 + 16 * tt + 4 * tq + 2 * (cl_ & 1) + (cl_ >> 1)] = s_; }
#undef CMW
#undef TMW
        }
        if (tq == 3) ex_gc[c] = gC_;
        LDS_BAR();
        }
        {
        f32x16 sc0, sc1, sc2, sc3, sc4;
        if (w == 2) {
            sc0 = score_t(A, SL_KCT, SL_QTT, 0, 0, true, lane); sc1 = score_t(A, SL_KCT, SL_QTT, 0, 1, true, lane); sc2 = score_t(A, SL_KCT, SL_QTT, 1, 1, true, lane);
            sc3 = score_t(A, SL_KCT, SL_RTT, 0, 0, false, lane); sc4 = score_t(A, SL_KCT, SL_RTT, 0, 1, false, lane);
        } else if (w == 3) {
            sc0 = score_t(A, SL_BCT, SL_RTT, 0, 0, false, lane); sc1 = score_t(A, SL_BCT, SL_RTT, 0, 1, false, lane); sc2 = score_t(A, SL_BCT, SL_RTT, 1, 1, false, lane);
            sc3 = score_t(A, SL_KCT, SL_RTT, 1, 1, false, lane);
        } else {
            neumann32(A, w, lane, sc0, sc1);
            if (w == 0) {
                f32x16 l21t;
#pragma unroll
                for (int i = 0; i < 16; ++i) { l21t[i] = 0.f; sc2[i] = 0.f; }
#pragma unroll
                for (int kk = 0; kk < 4; ++kk) l21t = MFMA32(ld_frag32(A, SL_BCT, 0, 16 * kk), ld_frag32(A, SL_QTT, 32, 16 * kk), l21t);
#pragma unroll
                for (int s = 0; s < 2; ++s) sc2 = MFMA32(pack32(l21t, s), pack32(sc0, s), sc2);
            }
        }
        LDS_BAR();
        if (w == 2) {
            write_c(A, SL_LKR, sc0, 0, 0); write_c(A, SL_LKR, sc1, 0, 32); write_c(A, SL_LKR, sc2, 32, 32);
            write_c(A, SL_MKR, sc3, 0, 0); write_c(A, SL_MKR, sc4, 0, 32);
        } else if (w == 3) {
            write_c(A, SL_MBR, sc0, 0, 0); write_c(A, SL_MBR, sc1, 0, 32); write_c(A, SL_MBR, sc2, 32, 32);
            write_c(A, SL_MKR, sc3, 32, 32);
        } else {
            write_c(A, SL_TR, sc1, 32 * w, 32 * w);
        }
        LDS_BAR();
        if (w == 0) {
            f32x16 t21t;
#pragma unroll
            for (int i = 0; i < 16; ++i) t21t[i] = 0.f;
#pragma unroll
            for (int s = 0; s < 2; ++s) t21t = MFMA32(pack32(sc2, s), ld_frag32p(A, SL_TR, 32, 32 + 16 * s), t21t);
#pragma unroll
            for (int i = 0; i < 16; ++i) t21t[i] = -t21t[i];
            write_c(A, SL_TR, t21t, 0, 32);
        }
        LDS_BAR();
        PRE_ISSUE(item + (int)gridDim.x, it_ + 1 < nitems);
        const size_t cc = ((size_t)(z * NGCHUNK + gchunk) * NH + h);
        if (w < 2) {
            const int cb = 32 * w;
            bf16* cmP = (bf16*)(p.ws + WS_CM_P) + cc * 4096; bf16* cmRP = (bf16*)(p.ws + WS_CM_RP) + cc * 4096;
            f32x16 W0, W1;
#pragma unroll
            for (int i = 0; i < 16; ++i) { W0[i] = 0.f; W1[i] = 0.f; }
#pragma unroll
            for (int kk = 0; kk < 2; ++kk) W0 = MFMA32(ld_frag32(A, SL_TR, 0, 16 * kk), ld_frag32(A, SL_QTC, cb, 16 * kk), W0);
#pragma unroll
            for (int kk = 0; kk < 4; ++kk) W1 = MFMA32(ld_frag32(A, SL_TR, 32, 16 * kk), ld_frag32(A, SL_QTC, cb, 16 * kk), W1);
            const bf16x8 pw00 = pack32(W0, 0), pw01 = pack32(W0, 1), pw10 = pack32(W1, 0), pw11 = pack32(W1, 1);
#pragma unroll
            for (int Cp = 0; Cp < 2; ++Cp) {
                f32x16 acc;
#pragma unroll
                for (int i = 0; i < 16; ++i) acc[i] = 0.f;
                acc = MFMA32(pw00, ld_frag32p(A, SL_BHC, 32 * Cp, 0), acc); acc = MFMA32(pw01, ld_frag32p(A, SL_BHC, 32 * Cp, 16), acc);
                acc = MFMA32(pw10, ld_frag32p(A, SL_BHC, 32 * Cp, 32), acc); acc = MFMA32(pw11, ld_frag32p(A, SL_BHC, 32 * Cp, 48), acc);
                const int cp = 32 * Cp + (lane & 31);
                if (Cp == w) {
                    const float gcv = ex_gc[cp];
#pragma unroll
                    for (int g = 0; g < 4; ++g) {
                        const int c0 = cb + 8 * g + 4 * hh;
                        float o_[4];
#pragma unroll
                        for (int rr = 0; rr < 4; ++rr) o_[rr] = ((c0 + rr == cp) ? gcv : 0.f) - acc[4 * g + rr];
                        u32x2 v_; v_.x = cvt2(o_[0], o_[1]); v_.y = cvt2(o_[2], o_[3]);
                        *(u32x2*)(cmP + ((c0 >> 2) * 64 + cp) * 4) = v_;
                    }
                } else {
#pragma unroll
                    for (int g = 0; g < 4; ++g) {
                        const int c0 = cb + 8 * g + 4 * hh;
                        u32x2 v_; v_.x = cvt2(-acc[4 * g], -acc[4 * g + 1]); v_.y = cvt2(-acc[4 * g + 2], -acc[4 * g + 3]);
                        *(u32x2*)(cmP + ((c0 >> 2) * 64 + cp) * 4) = v_;
                    }
                }
            }
#pragma unroll
            for (int Ip = 0; Ip < 2; ++Ip) {
                f32x16 acc;
#pragma unroll
                for (int i = 0; i < 16; ++i) acc[i] = 0.f;
                acc = MFMA32(pw00, ld_frag32p(A, SL_MBR, 32 * Ip, 0), acc); acc = MFMA32(pw01, ld_frag32p(A, SL_MBR, 32 * Ip, 16), acc);
                if (Ip == 1) { acc = MFMA32(pw10, ld_frag32p(A, SL_MBR, 32, 32), acc); acc = MFMA32(pw11, ld_frag32p(A, SL_MBR, 32, 48), acc); }
                const int i_ = 32 * Ip + (lane & 31), tl = z ? 63 - i_ : i_;
#pragma unroll
                for (int g = 0; g < 4; ++g) {
                    const int c0 = cb + 8 * g + 4 * hh;
                    const u32x2 rtv = *(const LAS u32x2*)ldsptr((A.vp ^ (unsigned)((cb / 8 + g) << 4)) + SL_RTT + 32 * Ip * 128);
                    u32x2 v_; v_.x = cvt2(bflo(rtv.x) - acc[4 * g], bfhi(rtv.x) - acc[4 * g + 1]); v_.y = cvt2(bflo(rtv.y) - acc[4 * g + 2], bfhi(rtv.y) - acc[4 * g + 3]);
                    *(u32x2*)(cmRP + ((c0 >> 2) * 64 + tl) * 4) = v_;
                }
            }
        } else {
            const int db = 32 * (w - 2);
            bf16* cmG = (bf16*)(p.ws + WS_CM_G) + cc * 4096; bf16* y0b = (bf16*)p.out + cc * 4096;
            f32x16 X0, X1, U0, U1;
#pragma unroll
            for (int i = 0; i < 16; ++i) { X0[i] = 0.f; X1[i] = 0.f; U0[i] = 0.f; U1[i] = 0.f; }
#pragma unroll
            for (int kk = 0; kk < 2; ++kk) X0 = MFMA32(ld_frag32(A, SL_LKR, 0, 16 * kk), ld_frag32(A, SL_VC, db, 16 * kk), X0);
#pragma unroll
            for (int kk = 0; kk < 4; ++kk) X1 = MFMA32(ld_frag32(A, SL_LKR, 32, 16 * kk), ld_frag32(A, SL_VC, db, 16 * kk), X1);
            { const bf16x8 px00 = pack32(X0, 0), px01 = pack32(X0, 1), px10 = pack32(X1, 0), px11 = pack32(X1, 1);
              U0 = MFMA32(ld_frag32p(A, SL_TR, 0, 0), px00, U0); U0 = MFMA32(ld_frag32p(A, SL_TR, 0, 16), px01, U0);
              U1 = MFMA32(ld_frag32p(A, SL_TR, 32, 0), px00, U1); U1 = MFMA32(ld_frag32p(A, SL_TR, 32, 16), px01, U1);
              U1 = MFMA32(ld_frag32p(A, SL_TR, 32, 32), px10, U1); U1 = MFMA32(ld_frag32p(A, SL_TR, 32, 48), px11, U1); }
            const bf16x8 nu00 = neg8(pack32(U0, 0)), nu01 = neg8(pack32(U0, 1)), nu10 = neg8(pack32(U1, 0)), nu11 = neg8(pack32(U1, 1));
            const int d_ = db + (lane & 31);
#pragma unroll
            for (int Cp = 0; Cp < 2; ++Cp) {
                f32x16 acc;
#pragma unroll
                for (int i = 0; i < 16; ++i) acc[i] = 0.f;
#pragma unroll
                for (int kk = 0; kk < 4; ++kk) acc = MFMA32(ld_frag32(A, SL_KHC, 32 * Cp, 16 * kk), ld_frag32(A, SL_VC, db, 16 * kk), acc);
                acc = MFMA32(ld_frag32p(A, SL_BHC, 32 * Cp, 0), nu00, acc); acc = MFMA32(ld_frag32p(A, SL_BHC, 32 * Cp, 16), nu01, acc);
                acc = MFMA32(ld_frag32p(A, SL_BHC, 32 * Cp, 32), nu10, acc); acc = MFMA32(ld_frag32p(A, SL_BHC, 32 * Cp, 48), nu11, acc);
#pragma unroll
                for (int g = 0; g < 4; ++g) { u32x2 v_; v_.x = cvt2(acc[4 * g], acc[4 * g + 1]); v_.y = cvt2(acc[4 * g + 2], acc[4 * g + 3]);
                    *(u32x2*)(cmG + (unsigned)(((8 * Cp + hh) * 64 + d_) * 4) + g * 512) = v_; }
            }
#pragma unroll
            for (int Ip = 0; Ip < 2; ++Ip) {
                f32x16 acc;
#pragma unroll
                for (int i = 0; i < 16; ++i) acc[i] = 0.f;
#pragma unroll
                for (int kk = 0; kk < 2; ++kk) acc = MFMA32(ld_frag32(A, SL_VC, db, 16 * kk), ld_frag32(A, SL_MKR, 32 * Ip, 16 * kk), acc);
                if (Ip == 1) {
#pragma unroll
                    for (int kk = 2; kk < 4; ++kk) acc = MFMA32(ld_frag32(A, SL_VC, db, 16 * kk), ld_frag32(A, SL_MKR, 32, 16 * kk), acc);
                }
                acc = MFMA32(nu00, ld_frag32p(A, SL_MBR, 32 * Ip, 0), acc); acc = MFMA32(nu01, ld_frag32p(A, SL_MBR, 32 * Ip, 16), acc);
                if (Ip == 1) { acc = MFMA32(nu10, ld_frag32p(A, SL_MBR, 32, 32), acc); acc = MFMA32(nu11, ld_frag32p(A, SL_MBR, 32, 48), acc); }
                const int i_ = 32 * Ip + (lane & 31), tl = z ? 63 - i_ : i_;
#pragma unroll
                for (int g = 0; g < 4; ++g) { u32x2 v_; v_.x = cvt2(acc[4 * g], acc[4 * g + 1]); v_.y = cvt2(acc[4 * g + 2], acc[4 * g + 3]);
                    *(u32x2*)(y0b + (unsigned)((((db >> 2) + hh) * 64 + tl) * 4) + g * 512) = v_; }
            }
            if (w == 2) {
                int j = lane; asm volatile("" : "+v"(j));
                const int tl = z ? 63 - j : j;
                float* bonus = (float*)(p.ws + WS_BONUS);
                bonus[((size_t)(z * NGCHUNK + gchunk) * NH + h) * 64 + tl] = (ex_bon[j] + ex_bon[64 + j]) + (ex_bon[128 + j] + ex_bon[192 + j]);
            }
        }
        LDS_BAR();
        }
    }
    __syncthreads();
}

#undef PRE_ISSUE
#undef LDS_BAR
constexpr size_t HOFF = (size_t)2 * 1536 * 8 * 4096;
__device__ __forceinline__ void rwkv_scan_chain(const Params& p, int z, int seq, int h, int w, int lane, int nb, int ne, f32x4 (&H)[4]) {
    int start, T; seq_info(seq, start, T);
    const int nchunk = T / 64, g0 = start / 64;
    const int cl_ = lane & 15, q = lane >> 4, d_ = 16 * w + cl_;
    const bf16* cmP = (const bf16*)(p.ws + WS_CM_P); const bf16* cmG = (const bf16*)(p.ws + WS_CM_G);
    bf16* hb_out = (bf16*)p.out + HOFF;
    bf16x8 ap[4][4][2]; u32x2 gv[4][4];
#define SCAN_CC(n_) ((size_t)(z * NGCHUNK + g0 + (z ? nchunk - 1 - (n_) : (n_))) * NH + h)
#define SCAN_LOAD(u_, n_) do { const size_t cc_ = SCAN_CC(n_); const bf16* pp_ = cmP + cc_ * 4096; const bf16* gg_ = cmG + cc_ * 4096; \
        _Pragma("unroll") for (int rt = 0; rt < 4; ++rt) { \
            _Pragma("unroll") for (int s_ = 0; s_ < 2; ++s_) { const u32x2 lo_ = *(const u32x2*)(pp_ + ((8 * s_ + q) * 64 + 16 * rt + cl_) * 4), hi_ = *(const u32x2*)(pp_ + ((8 * s_ + 4 + q) * 64 + 16 * rt + cl_) * 4); \
                ap[u_][rt][s_] = mk8(lo_.x, lo_.y, hi_.x, hi_.y); } \
            gv[u_][rt] = *(const u32x2*)(gg_ + ((4 * rt + q) * 64 + d_) * 4); } } while (0)
    unsigned tchP[8], tchG[8];
#define SCAN_TOUCH(t_, n_) do { const size_t cc_ = SCAN_CC(n_); \
        tchP[t_] = *(const unsigned*)((const char*)(cmP + cc_ * 4096) + lane * 128); \
        tchG[t_] = *(const unsigned*)((const char*)(cmG + cc_ * 4096) + cl_ * 512 + w * 128); } while (0)
#pragma unroll
    for (int u = 0; u < 4; ++u) SCAN_LOAD(u, nb + u);
#pragma unroll
    for (int t = 0; t < 8; ++t) { tchP[t] = 0u; tchG[t] = 0u; if (nb + t + 4 < ne) SCAN_TOUCH(t, nb + t + 4); }
    for (int n0 = nb; n0 < ne; n0 += 8) {
#pragma unroll
        for (int t = 0; t < 8; ++t) {
            const int n = n0 + t, u = t & 3;
            unsigned hw[4][2];
#pragma unroll
            for (int rt = 0; rt < 4; ++rt) { hw[rt][0] = cvt2(H[rt][0], H[rt][1]); hw[rt][1] = cvt2(H[rt][2], H[rt][3]); }
            bf16* ho = hb_out + SCAN_CC(n) * 4096 + (q * 64 + d_) * 4;
#pragma unroll
            for (int rt = 0; rt < 4; ++rt) { u32x2 v_; v_.x = hw[rt][0]; v_.y = hw[rt][1]; *(u32x2*)(ho + rt * 1024) = v_; }
            const bf16x8 hb0 = mk8(hw[0][0], hw[0][1], hw[1][0], hw[1][1]), hb1 = mk8(hw[2][0], hw[2][1], hw[3][0], hw[3][1]);
#pragma unroll
            for (int rt = 0; rt < 4; ++rt) {
                f32x4 acc = {bflo(gv[u][rt].x), bfhi(gv[u][rt].x), bflo(gv[u][rt].y), bfhi(gv[u][rt].y)};
                acc = MFMA16(ap[u][rt][0], hb0, acc); acc = MFMA16(ap[u][rt][1], hb1, acc);
                H[rt] = acc;
            }
            if (n + 4 < ne) SCAN_LOAD(u, n + 4);
            asm volatile("" :: "v"(tchP[t]), "v"(tchG[t]));
            if (n + 12 < ne) SCAN_TOUCH(t, n + 12);
        }
    }
#undef SCAN_LOAD
#undef SCAN_TOUCH
#undef SCAN_CC
}
__device__ __forceinline__ void mix_phase3(const Params& p, LAS unsigned char* lds_wg, int wave, int lane_in, int item_lo, int item_hi, int slot, int nslots) {
    const bf16* Z = (const bf16*)(p.ws + WS_Z);
    bf16* MX = (bf16*)(p.ws + WS_MIXED);
    const float* bonus = (const float*)(p.ws + WS_BONUS);
    const bf16* cmRP = (const bf16*)(p.ws + WS_CM_RP); const bf16* y0b = (const bf16*)p.out; const bf16* hb_in = (const bf16*)p.out + HOFF;
    LAS unsigned char* lds = lds_wg + wave * 16384;
    const unsigned lb = (unsigned)(size_t)lds;
    for (int item = item_lo + slot; item < item_hi; item += nslots) {
        int lane_o = lane_in; asm volatile("" : "+v"(lane_o));
        const int lane = lane_o, l31 = lane & 31, hh = lane >> 5;
        const unsigned vp = lb + l31 * 128 + ((((l31 >> 1) & 7)) << 4) + 8 * hh;
        const int h = item & 7, gchunk = item >> 3, m0 = gchunk * 64;
        int tpos0, T; seq_of_token(m0, tpos0, T);
        const int ch = lane & 7;
        const f32x4 mv0 = *(const f32x4*)(p.shift_mu + C_V + h * 64 + 8 * ch), mv1 = *(const f32x4*)(p.shift_mu + C_V + h * 64 + 8 * ch + 4);
        const f32x4 mg0 = *(const f32x4*)(p.shift_mu + C_G + h * 64 + 8 * ch), mg1 = *(const f32x4*)(p.shift_mu + C_G + h * 64 + 8 * ch + 4);
        const float muv[8] = {mv0.x, mv0.y, mv0.z, mv0.w, mv1.x, mv1.y, mv1.z, mv1.w}, mug[8] = {mg0.x, mg0.y, mg0.z, mg0.w, mg1.x, mg1.y, mg1.z, mg1.w};
#pragma unroll 1
        for (int it0 = 0; it0 < 8; it0 += 4) {
            u32x4 v0[4], g0[4], vm[4], vq[4], gm[4], gq[4]; float bon[4];
#pragma unroll
            for (int r = 0; r < 4; ++r) {
                const int row = (it0 + r) * 8 + (lane >> 3), m = m0 + row, tp = tpos0 + row;
                const bf16* zv = ZS(Z, m, C_V + h * 64 + 8 * ch); const bf16* zg = ZS(Z, m, C_G + h * 64 + 8 * ch);
                const int dm = tp > 0 ? ZW : 0, dq = tp < T - 1 ? ZW : 0;
                v0[r] = *(const u32x4*)zv; g0[r] = *(const u32x4*)zg;
                vm[r] = *(const u32x4*)(zv - dm); gm[r] = *(const u32x4*)(zg - dm);
                vq[r] = *(const u32x4*)(zv + dq); gq[r] = *(const u32x4*)(zg + dq);
                bon[r] = bonus[((size_t)gchunk * NH + h) * 64 + row] + bonus[((size_t)(NGCHUNK + gchunk) * NH + h) * 64 + row];
            }
#pragma unroll
            for (int r = 0; r < 4; ++r) {
                const int row = (it0 + r) * 8 + (lane >> 3), tp = tpos0 + row;
                const u32x4 z4 = {0u, 0u, 0u, 0u};
                const u32x4 a = v0[r], b = g0[r], am_ = tp > 0 ? vm[r] : z4, bm_ = tp > 0 ? gm[r] : z4, aq_ = tp < T - 1 ? vq[r] : z4, bq_ = tp < T - 1 ? gq[r] : z4;
                const float fv0[8] = {bflo(a.x), bfhi(a.x), bflo(a.y), bfhi(a.y), bflo(a.z), bfhi(a.z), bflo(a.w), bfhi(a.w)};
                const float fvm[8] = {bflo(am_.x), bfhi(am_.x), bflo(am_.y), bfhi(am_.y), bflo(am_.z), bfhi(am_.z), bflo(am_.w), bfhi(am_.w)};
                const float fvq[8] = {bflo(aq_.x), bfhi(aq_.x), bflo(aq_.y), bfhi(aq_.y), bflo(aq_.z), bfhi(aq_.z), bflo(aq_.w), bfhi(aq_.w)};
                const float fg0[8] = {bflo(b.x), bfhi(b.x), bflo(b.y), bfhi(b.y), bflo(b.z), bfhi(b.z), bflo(b.w), bfhi(b.w)};
                const float fgm[8] = {bflo(bm_.x), bfhi(bm_.x), bflo(bm_.y), bfhi(bm_.y), bflo(bm_.z), bfhi(bm_.z), bflo(bm_.w), bfhi(bm_.w)};
                const float fgq[8] = {bflo(bq_.x), bfhi(bq_.x), bflo(bq_.y), bfhi(bq_.y), bflo(bq_.z), bfhi(bq_.z), bflo(bq_.w), bfhi(bq_.w)};
                float av_[8], sg_[8];
#pragma unroll
                for (int e = 0; e < 8; ++e) {
                    av_[e] = bon[r] * (fv0[e] + muv[e] * (0.5f * (fvm[e] + fvq[e]) - fv0[e]));
                    const float gt = fg0[e] + mug[e] * (0.5f * (fgm[e] + fgq[e]) - fg0[e]);
                    sg_[e] = gt * sigmoidf_(gt);
                }
                u32x4 oa, os; oa.x = cvt2(av_[0], av_[1]); oa.y = cvt2(av_[2], av_[3]); oa.z = cvt2(av_[4], av_[5]); oa.w = cvt2(av_[6], av_[7]);
                os.x = cvt2(sg_[0], sg_[1]); os.y = cvt2(sg_[2], sg_[3]); os.z = cvt2(sg_[4], sg_[5]); os.w = cvt2(sg_[6], sg_[7]);
                *(LAS u32x4*)(lds + sw_addr(0, row, ch * 16)) = oa; *(LAS u32x4*)(lds + sw_addr(8192, row, ch * 16)) = os;
            }
        }
        f32x16 acc[2][2];
        const size_t cc0 = ((size_t)(0 * NGCHUNK + gchunk) * NH + h) * 4096, cc1 = ((size_t)(1 * NGCHUNK + gchunk) * NH + h) * 4096;
#pragma unroll
        for (int D = 0; D < 2; ++D)
#pragma unroll
            for (int I = 0; I < 2; ++I)
#pragma unroll
                for (int g = 0; g < 4; ++g) {
                    const size_t off = (size_t)((8 * D + 2 * g + hh) * 64 + 32 * I + l31) * 4;
                    const u32x2 a = *(const u32x2*)(y0b + cc0 + off), b = *(const u32x2*)(y0b + cc1 + off);
                    acc[D][I][4 * g + 0] = bflo(a.x) + bflo(b.x); acc[D][I][4 * g + 1] = bfhi(a.x) + bfhi(b.x);
                    acc[D][I][4 * g + 2] = bflo(a.y) + bflo(b.y); acc[D][I][4 * g + 3] = bfhi(a.y) + bfhi(b.y);
                }
#pragma unroll
        for (int zz = 0; zz < 2; ++zz) {
            const bf16* hp = hb_in + (zz ? cc1 : cc0); const bf16* rp = cmRP + (zz ? cc1 : cc0);
#pragma unroll
            for (int kk = 0; kk < 4; ++kk) {
                bf16x8 fa[2], fb[2];
#pragma unroll
                for (int t = 0; t < 2; ++t) { const int o_ = ((4 * kk + 2 * hh) * 64 + 32 * t + l31) * 4;
                    const u32x2 a0 = *(const u32x2*)(hp + o_), a1 = *(const u32x2*)(hp + o_ + 256), b0 = *(const u32x2*)(rp + o_), b1 = *(const u32x2*)(rp + o_ + 256);
                    fa[t] = mk8(a0.x, a0.y, a1.x, a1.y); fb[t] = mk8(b0.x, b0.y, b1.x, b1.y); }
#pragma unroll
                for (int D = 0; D < 2; ++D)
#pragma unroll
                    for (int I = 0; I < 2; ++I) acc[D][I] = MFMA32(fa[D], fb[I], acc[D][I]);
            }
        }
#pragma unroll
        for (int I = 0; I < 2; ++I) {
            float s1 = 0.f;
#pragma unroll
            for (int D = 0; D < 2; ++D)
#pragma unroll
                for (int r_ = 0; r_ < 16; ++r_) s1 += acc[D][I][r_];
            s1 = add_xor32(s1);
            const float mean = s1 * (1.0f / 64.0f);
            float s2 = 0.f;
#pragma unroll
            for (int D = 0; D < 2; ++D)
#pragma unroll
                for (int r_ = 0; r_ < 16; ++r_) { const float dlt = acc[D][I][r_] - mean; s2 += dlt * dlt; }
            s2 = add_xor32(s2);
            const float rstd = 1.0f / sqrtf(s2 * (1.0f / 64.0f) + 64e-5f);
#pragma unroll
            for (int D = 0; D < 2; ++D)
#pragma unroll
                for (int g = 0; g < 4; ++g) {
                    const int d0 = 32 * D + 8 * g + 4 * hh;
                    const f32x4 lg = *(const f32x4*)(p.lnx_g + h * 64 + d0), lbv = *(const f32x4*)(p.lnx_b + h * 64 + d0);
                    const unsigned ad = (vp ^ (unsigned)((4 * D + g) << 4)) + 32 * I * 128;
                    const u32x2 av_ = *(const LAS u32x2*)ldsptr(ad), sg_ = *(const LAS u32x2*)ldsptr(ad + 8192);
                    const float r0 = ((acc[D][I][4 * g + 0] - mean) * rstd * lg.x + lbv.x + bflo(av_.x)) * bflo(sg_.x);
                    const float r1 = ((acc[D][I][4 * g + 1] - mean) * rstd * lg.y + lbv.y + bfhi(av_.x)) * bfhi(sg_.x);
                    const float r2 = ((acc[D][I][4 * g + 2] - mean) * rstd * lg.z + lbv.z + bflo(av_.y)) * bflo(sg_.y);
                    const float r3 = ((acc[D][I][4 * g + 3] - mean) * rstd * lg.w + lbv.w + bfhi(av_.y)) * bfhi(sg_.y);
                    u32x2 o; o.x = cvt2(r0, r1); o.y = cvt2(r2, r3);
                    *(LAS u32x2*)ldsptr(ad) = o;
                }
        }
#pragma unroll 2
        for (int it = 0; it < 8; ++it) {
            const int row = it * 8 + (lane >> 3), ch = lane & 7, m = m0 + row;
            const u32x4 o = *(const LAS u32x4*)(lds + sw_addr(0, row, ch * 16));
            *(u32x4*)(MX + (size_t)m * 512 + h * 64 + 8 * ch) = o;
        }
    }
}

constexpr unsigned NA_K = 0, NA_VT = 9 * 8192, NA_VT_SLOT = 64 * 136, NA_TBL = NA_VT + 9 * NA_VT_SLOT;
static_assert(NA_TBL + 15 * 64 * 4 <= LDS_BYTES - 16, "NA LDS map");
constexpr int NA_PAIRS = 2 * 8 * 128 + 16 * 8 * 32;
struct NaRow { u32x4 k, v; };
__device__ __forceinline__ NaRow na_row_issue(const Params& p, int start, int head, int rho, int tid) {
    const bf16* Z = (const bf16*)(p.ws + WS_Z);
    NaRow r;
    r.k = *(const u32x4*)ZS(Z, start + rho * 64 + (tid >> 3), C_AK + head * 64 + 8 * (tid & 7));
    r.v = *(const u32x4*)ZS(Z, start + rho * 64 + (tid & 63), C_AV + head * 64 + 8 * (tid >> 6));
    return r;
}
__device__ __forceinline__ void na_row_commit(LAS unsigned char* lds, int rho, int tid, const NaRow& r, const f32x4& g0, const f32x4& g1) {
    const int slot = rho % 9;
    {
        const int col = tid >> 3, ch = tid & 7;
        const u32x4 w = r.k;
        float f[8] = {bflo(w.x), bfhi(w.x), bflo(w.y), bfhi(w.y), bflo(w.z), bfhi(w.z), bflo(w.w), bfhi(w.w)};
        float ss = 0.f;
#pragma unroll
        for (int e = 0; e < 8; ++e) ss += f[e] * f[e];
        ss = dpp_sum8(ss);
        const float rstd = __builtin_amdgcn_rsqf(ss * (1.0f / 64.0f) + 1e-6f);
        u32x4 o; o.x = cvt2(f[0] * rstd * g0.x, f[1] * rstd * g0.y); o.y = cvt2(f[2] * rstd * g0.z, f[3] * rstd * g0.w);
        o.z = cvt2(f[4] * rstd * g1.x, f[5] * rstd * g1.y); o.w = cvt2(f[6] * rstd * g1.z, f[7] * rstd * g1.w);
        *(LAS u32x4*)(lds + NA_K + slot * 8192 + col * 128 + ((ch ^ ((col >> 1) & 7)) << 4)) = o;
    }
    {
        const int ch = tid >> 6, col = tid & 63;
        const u32x4 w = r.v;
        LAS unsigned short* vt = (LAS unsigned short*)(lds + NA_VT + slot * NA_VT_SLOT + (32 * (ch >> 2) + 4 * (ch & 3)) * 136 + col * 2);
        vt[0 * 68] = (unsigned short)(w.x & 0xffffu); vt[1 * 68] = (unsigned short)(w.x >> 16); vt[2 * 68] = (unsigned short)(w.y & 0xffffu); vt[3 * 68] = (unsigned short)(w.y >> 16);
        vt[16 * 68] = (unsigned short)(w.z & 0xffffu); vt[17 * 68] = (unsigned short)(w.z >> 16); vt[18 * 68] = (unsigned short)(w.w & 0xffffu); vt[19 * 68] = (unsigned short)(w.w >> 16);
    }
}
__device__ __forceinline__ void na_pair_info(int gp, int& seq, int& head, int& pr, int& R) {
    if (gp < 2048) { const int u = gp >> 7; seq = u >> 3; head = u & 7; pr = gp & 127; R = 256; }
    else { const int g2 = gp - 2048, u = g2 >> 5; seq = 2 + (u >> 3); head = u & 7; pr = g2 & 31; R = 64; }
}
__device__ __forceinline__ void na_phase(const Params& p, LAS unsigned char* lds, int wave, int lane) {
    const bf16* Z = (const bf16*)(p.ws + WS_Z);
    bf16* YAo = (bf16*)(p.ws + WS_YA);
    const int tid = threadIdx.x, cl = lane & 15, q4 = lane >> 4, rw = wave >> 2, qb = wave & 3;
    const int kw0 = (qb == 0) ? 0 : (qb == 1 ? 8 : (qb == 2 ? 24 : 32));
    const int qc = 16 * qb + cl;
    constexpr float LOG2E = 1.4426950408889634f;
    float vf[2][4];
    { int cs = qc - 8; cs = cs < 0 ? 0 : (cs > 48 ? 48 : cs);
#pragma unroll
      for (int ct = 0; ct < 2; ++ct)
#pragma unroll
        for (int reg = 0; reg < 4; ++reg) { const int kc = kw0 + 16 * ct + 4 * q4 + reg; vf[ct][reg] = (kc >= cs && kc < cs + 16) ? 1.f : 0.f; } }
    const unsigned lbase = (unsigned)(size_t)lds;
    const unsigned vK = lbase + NA_K + (kw0 + cl) * 128 + (((q4 ^ (((kw0 >> 1) + (cl >> 1)) & 7)) & 7) << 4);
    const unsigned vV = lbase + NA_VT + cl * 136 + (kw0 + 4 * q4) * 2;
    const unsigned vB = lbase + NA_TBL + (kw0 + 4 * q4 - 16 * qb - cl + 31) * 4;
    float gq[2][8];
#pragma unroll
    for (int s = 0; s < 2; ++s)
#pragma unroll
        for (int e = 0; e < 8; ++e) gq[s][e] = p.q_norm_g[32 * s + 8 * q4 + e] * (0.125f * LOG2E);
    f32x4 kg0 = *(const f32x4*)(p.k_norm_g + 8 * (tid & 7)), kg1 = *(const f32x4*)(p.k_norm_g + 8 * (tid & 7) + 4);
    asm volatile("" : "+v"(kg0), "+v"(kg1));
    int cur_unit = -1, have_hi = -1;
    u32x4 qn[2]; qn[0] = (u32x4){0u, 0u, 0u, 0u}; qn[1] = qn[0];
    const int na_per = (NA_PAIRS + (int)gridDim.x - 1) / (int)gridDim.x;
    if ((int)blockIdx.x * na_per < NA_PAIRS) {
        int s0, h0, pr0, R0; na_pair_info((int)blockIdx.x * na_per, s0, h0, pr0, R0);
        int st0, ln0; seq_info(s0, st0, ln0); const int mq0 = st0 + (2 * pr0 + rw) * 64 + qc;
        qn[0] = *(const u32x4*)ZS(Z, mq0, C_AQ + h0 * 64 + 8 * q4); qn[1] = *(const u32x4*)ZS(Z, mq0, C_AQ + h0 * 64 + 32 + 8 * q4);
    }
    for (int k = 0; k < na_per; ++k) {
        const int gp = blockIdx.x * na_per + k;
        if (gp >= NA_PAIRS) break;
        int seq, head, pr, R; na_pair_info(gp, seq, head, pr, R);
        int start, len; seq_info(seq, start, len);
        const int r = 2 * pr;
        int lo = r - 4; lo = lo < 0 ? 0 : (lo > R - 8 ? R - 8 : lo);
        int hi = r - 3; hi = (hi < 0 ? 0 : (hi > R - 8 ? R - 8 : hi)) + 7;
        const int unit = seq * 8 + head;
        int first = have_hi + 1;
        if (unit != cur_unit) {
            first = lo;
            for (int i = tid; i < 15 * 64; i += NTHREADS) { const int dr = i >> 6, dc = (i & 63) - 16;
                ((LAS float*)(lds + NA_TBL))[i] = (dc >= 0 && dc <= 30) ? p.rpb[(head * 15 + dr) * 31 + dc] * LOG2E : 0.f; }
        }
        {
            NaRow rws[9];
#pragma unroll
            for (int i = 0; i < 9; ++i) { rws[i].k = (u32x4){0u, 0u, 0u, 0u}; rws[i].v = rws[i].k; if (first + i <= hi) rws[i] = na_row_issue(p, start, head, first + i, tid); }
#pragma unroll
            for (int i = 0; i < 9; ++i) if (first + i <= hi) na_row_commit(lds, first + i, tid, rws[i], kg0, kg1);
        }
        cur_unit = unit; have_hi = hi;
        __syncthreads();
        int nrow0 = 0, nrows = 0; NaRow nx0, nx1;
        nx0.k = (u32x4){0u, 0u, 0u, 0u}; nx0.v = nx0.k; nx1 = nx0;
        u32x4 qnx0 = {0u, 0u, 0u, 0u}, qnx1 = {0u, 0u, 0u, 0u}; bool qnx = false;
        if (k + 1 < na_per && gp + 1 < NA_PAIRS) {
            int s2, h2, pr2, R2; na_pair_info(gp + 1, s2, h2, pr2, R2);
            { int st2, ln2; seq_info(s2, st2, ln2); const int mq2 = st2 + (2 * pr2 + rw) * 64 + qc;
              qnx0 = *(const u32x4*)ZS(Z, mq2, C_AQ + h2 * 64 + 8 * q4); qnx1 = *(const u32x4*)ZS(Z, mq2, C_AQ + h2 * 64 + 32 + 8 * q4); qnx = true; }
            if (s2 * 8 + h2 == unit) {
                int hi2 = 2 * pr2 - 3; hi2 = (hi2 < 0 ? 0 : (hi2 > R2 - 8 ? R2 - 8 : hi2)) + 7;
                nrow0 = hi + 1; nrows = hi2 - hi;
                if (nrows > 0) nx0 = na_row_issue(p, start, head, nrow0, tid);
                if (nrows > 1) nx1 = na_row_issue(p, start, head, nrow0 + 1, tid);
            }
        }
        const int rq = r + rw;
        int kr0 = rq - 4; kr0 = kr0 < 0 ? 0 : (kr0 > R - 8 ? R - 8 : kr0);
        const int mq = start + rq * 64 + qc;
        u32x4 gw[2];
#pragma unroll
        for (int a = 0; a < 2; ++a) gw[a] = *(const u32x4*)ZS(Z, mq, C_AG + head * 64 + 32 * a + 8 * q4);
        bf16x8 qf[2];
        { float f[2][8]; float ss = 0.f;
          u32x4 qw[2];
          qw[0] = qn[0]; qw[1] = qn[1];
#pragma unroll
          for (int s = 0; s < 2; ++s) { const u32x4 w = qw[s];
              f[s][0] = bflo(w.x); f[s][1] = bfhi(w.x); f[s][2] = bflo(w.y); f[s][3] = bfhi(w.y); f[s][4] = bflo(w.z); f[s][5] = bfhi(w.z); f[s][6] = bflo(w.w); f[s][7] = bfhi(w.w);
#pragma unroll
              for (int e = 0; e < 8; ++e) ss += f[s][e] * f[s][e]; }
          ss = add_xor32(add_xor16(ss));
          const float rstd = __builtin_amdgcn_rsqf(ss * (1.0f / 64.0f) + 1e-6f);
#pragma unroll
          for (int s = 0; s < 2; ++s) qf[s] = mk8(cvt2(f[s][0] * rstd * gq[s][0], f[s][1] * rstd * gq[s][1]), cvt2(f[s][2] * rstd * gq[s][2], f[s][3] * rstd * gq[s][3]),
                                                  cvt2(f[s][4] * rstd * gq[s][4], f[s][5] * rstd * gq[s][5]), cvt2(f[s][6] * rstd * gq[s][6], f[s][7] * rstd * gq[s][7])); }
        f32x4 S[8][2];
        float mx = -1e30f;
        const unsigned vBr = vB + (unsigned)((kr0 - rq + 7) * 256);
        const int slot0 = kr0 % 9;
        {
            bf16x8 kf[2][2][2]; float bb[2][2][4];
#define NA_LDK(buf_, kr_, ks_) do { _Pragma("unroll") for (int ct = 0; ct < 2; ++ct) { \
                _Pragma("unroll") for (int s_ = 0; s_ < 2; ++s_) kf[buf_][ct][s_] = *(const LAS bf16x8*)ldsptr((vK ^ (unsigned)(s_ << 6)) + (ks_) + ct * 2048); \
                _Pragma("unroll") for (int reg = 0; reg < 4; ++reg) bb[buf_][ct][reg] = *(const LAS float*)ldsptr(vBr + (kr_) * 256 + (16 * ct + reg) * 4); } } while (0)
            int slot = slot0;
            NA_LDK(0, 0, (unsigned)(slot * 8192));
#pragma unroll
            for (int kr = 0; kr < 8; ++kr) {
                if (kr < 7) { slot = (slot == 8) ? 0 : slot + 1; NA_LDK((kr + 1) & 1, kr + 1, (unsigned)(slot * 8192)); }
#pragma unroll
                for (int ct = 0; ct < 2; ++ct) {
                    f32x4 acc = {0.f, 0.f, 0.f, 0.f};
#pragma unroll
                    for (int s_ = 0; s_ < 2; ++s_) acc = MFMA16(kf[kr & 1][ct][s_], qf[s_], acc);
#pragma unroll
                    for (int reg = 0; reg < 4; ++reg) { acc[reg] += bb[kr & 1][ct][reg]; mx = fmaxf(mx, acc[reg]); }
                    S[kr][ct] = acc;
                }
            }
#undef NA_LDK
        }
        mx = max_xor32(max_xor16(mx));
        float lsum = 0.f;
        f32x4 O[4];
#pragma unroll
        for (int dt = 0; dt < 4; ++dt) O[dt] = (f32x4){0.f, 0.f, 0.f, 0.f};
        {
            u32x2 vfr[2][4][2];
#define NA_LDV(buf_, vs_) do { _Pragma("unroll") for (int dt = 0; dt < 4; ++dt) { vfr[buf_][dt][0] = *(const LAS u32x2*)ldsptr(vV + (vs_) + dt * 2176); vfr[buf_][dt][1] = *(const LAS u32x2*)ldsptr(vV + (vs_) + dt * 2176 + 32); } } while (0)
            int slot = slot0;
            NA_LDV(0, (unsigned)(slot * NA_VT_SLOT));
#pragma unroll
            for (int kr = 0; kr < 8; ++kr) {
                if (kr < 7) { slot = (slot == 8) ? 0 : slot + 1; NA_LDV((kr + 1) & 1, (unsigned)(slot * NA_VT_SLOT)); }
                float pe[2][4];
#pragma unroll
                for (int ct = 0; ct < 2; ++ct)
#pragma unroll
                    for (int reg = 0; reg < 4; ++reg) { pe[ct][reg] = __builtin_amdgcn_exp2f(S[kr][ct][reg] - mx) * vf[ct][reg]; lsum += pe[ct][reg]; }
                const bf16x8 pa = mk8(cvt2(pe[0][0], pe[0][1]), cvt2(pe[0][2], pe[0][3]), cvt2(pe[1][0], pe[1][1]), cvt2(pe[1][2], pe[1][3]));
#pragma unroll
                for (int dt = 0; dt < 4; ++dt)
                    O[dt] = MFMA16(mk8(vfr[kr & 1][dt][0].x, vfr[kr & 1][dt][0].y, vfr[kr & 1][dt][1].x, vfr[kr & 1][dt][1].y), pa, O[dt]);
            }
#undef NA_LDV
        }
        lsum = add_xor32(add_xor16(lsum));
        const float linv = __builtin_amdgcn_rcpf(lsum);
        {
            bf16* yt = YAo + (size_t)mq * 512 + head * 64 + 8 * q4;
#pragma unroll
            for (int a = 0; a < 2; ++a) {
                u32x4 v_;
                { const float g0 = bflo(gw[a].x), g1 = bfhi(gw[a].x), g2 = bflo(gw[a].y), g3 = bfhi(gw[a].y);
                  v_.x = cvt2(O[2 * a][0] * linv * (g0 * fsigmoid(g0)), O[2 * a][1] * linv * (g1 * fsigmoid(g1)));
                  v_.y = cvt2(O[2 * a][2] * linv * (g2 * fsigmoid(g2)), O[2 * a][3] * linv * (g3 * fsigmoid(g3))); }
                { const float g0 = bflo(gw[a].z), g1 = bfhi(gw[a].z), g2 = bflo(gw[a].w), g3 = bfhi(gw[a].w);
                  v_.z = cvt2(O[2 * a + 1][0] * linv * (g0 * fsigmoid(g0)), O[2 * a + 1][1] * linv * (g1 * fsigmoid(g1)));
                  v_.w = cvt2(O[2 * a + 1][2] * linv * (g2 * fsigmoid(g2)), O[2 * a + 1][3] * linv * (g3 * fsigmoid(g3))); }
                *(u32x4*)(yt + 32 * a) = v_; }
        }
        __syncthreads();
        if (nrows > 0) na_row_commit(lds, nrow0, tid, nx0, kg0, kg1);
        if (nrows > 1) na_row_commit(lds, nrow0 + 1, tid, nx1, kg0, kg1);
        have_hi += nrows;
        qn[0] = qnx0; qn[1] = qnx1;
    }
}

__global__ void __launch_bounds__(NTHREADS, 2) fwd_megakernel(Params p) {
    extern __shared__ __attribute__((aligned(16))) unsigned char lds_raw[];
    LAS unsigned char* lds = (LAS unsigned char*)lds_raw;
    const int tid = threadIdx.x, lane = tid & 63, wave = __builtin_amdgcn_readfirstlane(tid >> 6);
    volatile LAS unsigned* bar_st = (volatile LAS unsigned*)(lds + LDS_BYTES - 16);
    if (tid == 0) { bar_st[0] = 0u; bar_st[1] = 0u; bar_st[2] = 0u; bar_st[3] = 0u; }
    __syncthreads();
    XcdBarrier gbar = xcd_barrier_post((unsigned*)(p.ws + WS_CTL) + 4096, bar_st);
#ifndef NO_P0
    for (int rep = 0; rep < PROBE_REP_P0; ++rep) p0_prologue(p, lds, wave, lane);
#endif
    xcd_barrier(gbar);
#ifndef NO_G1
    { pg8::Gemm g{(const pg8::bf16_t*)p.out, (const pg8::bf16_t*)(p.ws + WS_WINT), M_TOK, DINP, DM, DM, (const pg8::bf16_t*)p.out, DM / 64};
      pg8::StaticOrder S; S.init(M_TOK, DINP, (int)gridDim.x, (int)blockIdx.x, (DINP - DIN == 128) ? 1 : 0);
      pg8::EpiBf16<0> E{(pg8::bf16_t*)(p.ws + WS_Z), 64, nullptr, 0, ZSLAB};
      pg8::gemm_phase<pg8::EpiBf16<0>, pg8::StaticOrder>((PG8_LAS unsigned char*)lds, g, S, E, nullptr); }
#endif
    xcd_barrier(gbar);
    lora_prep_phase(p);
    xcd_barrier(gbar);
#ifndef NO_NA
    for (int rep = 0; rep < PROBE_REP_NA; ++rep) { na_phase(p, lds, wave, lane); __syncthreads(); }
#endif
#ifndef NO_PRE
    for (int rep = 0; rep < PROBE_REP_PRE; ++rep) rwkv_pre_phase(p, lds, wave, lane);
#endif
    xcd_barrier(gbar);
    {
        int b_ = blockIdx.x; asm volatile("" : "+s"(b_));
        int lane_s = lane; asm volatile("" : "+v"(lane_s));
        const int b = b_, G = gridDim.x;
        const bool split = (G >= 128), prompt_wave = split && wave == 4 && b < 128;
        f32x4 Hs[4];
#pragma unroll
        for (int i = 0; i < 4; ++i) Hs[i] = (f32x4){0.f, 0.f, 0.f, 0.f};
        const int pch = b >> 2;
        if (wave < 4) { for (int q = b; q < 256; q += G) { f32x4 Hq[4];
#pragma unroll
                for (int i = 0; i < 4; ++i) Hq[i] = (f32x4){0.f, 0.f, 0.f, 0.f};
                rwkv_scan_chain(p, q & 1, 2 + (q >> 4), (q >> 1) & 7, wave, lane_s, 0, T_SAMPLE / 64, Hq); } }
        else if (prompt_wave) rwkv_scan_chain(p, pch & 1, pch >> 4, (pch >> 1) & 7, b & 3, lane_s, 0, 64, Hs);
        else if (!split && wave == 4) { for (int pw = b; pw < 128; pw += G) { const int ch = pw >> 2; f32x4 Hq[4];
#pragma unroll
                for (int i = 0; i < 4; ++i) Hq[i] = (f32x4){0.f, 0.f, 0.f, 0.f};
                rwkv_scan_chain(p, ch & 1, ch >> 4, (ch >> 1) & 7, pw & 3, lane_s, 0, T_PROMPT / 64, Hq); } }
        xcd_barrier(gbar);
        const int nb7 = split ? 128 : 0;
        const int n_prompt_items = 2 * (T_PROMPT / 64) * NH;
        if (prompt_wave) rwkv_scan_chain(p, pch & 1, pch >> 4, (pch >> 1) & 7, b & 3, lane_s, 64, T_PROMPT / 64, Hs);
        else {
            const int slot = (b < nb7) ? b * 7 + (wave < 4 ? wave : wave - 1) : nb7 * 7 + (b - nb7) * 8 + wave;
            mix_phase3(p, lds, wave, lane_s, n_prompt_items, NGCHUNK * NH, slot, nb7 * 7 + (G - nb7) * 8);
        }
        xcd_barrier(gbar);
        mix_phase3(p, lds, wave, lane_s, 0, n_prompt_items, b * NWAVES + wave, G * NWAVES);
    }
    xcd_barrier(gbar);
#ifndef NO_G2
    { pg8::Gemm g{(const pg8::bf16_t*)(p.ws + WS_MIXED), (const pg8::bf16_t*)(p.ws + WS_WOUTT), M_TOK, DM, DM, DRW, (const pg8::bf16_t*)(p.ws + WS_YA), DRW / 64};
      pg8::StaticOrder S; S.init(M_TOK, DM, (int)gridDim.x, (int)blockIdx.x);
      pg8::EpiResF32 E{p.x_prompt, p.x_sample, p.out};
      pg8::gemm_phase<pg8::EpiResF32, pg8::StaticOrder>((PG8_LAS unsigned char*)lds, g, S, E, nullptr); }
#endif
}

extern "C" void kernel_launch(void* const* d_in, const int* in_sizes, int n_in, void* d_out, int out_size,
                              void* d_ws, size_t ws_size, hipStream_t stream) {
    static int grid_blocks = 0;
    if (grid_blocks == 0) {
        if (n_in != 18 || out_size != M_TOK * DM || ws_size < WS_END) {
            fprintf(stderr, "kernel_launch: unexpected shapes (n_in %d out %d ws %zu need %zu); nothing launched\n", n_in, out_size, ws_size, (size_t)WS_END);
            grid_blocks = -1; return; }
        int dev = 0, cus = 0, per_cu = 0;
        (void)hipGetDevice(&dev);
        (void)hipDeviceGetAttribute(&cus, hipDeviceAttributeMultiprocessorCount, dev);
        (void)hipFuncSetAttribute((const void*)fwd_megakernel, hipFuncAttributeMaxDynamicSharedMemorySize, LDS_BYTES);
        (void)hipOccupancyMaxActiveBlocksPerMultiprocessor(&per_cu, fwd_megakernel, NTHREADS, LDS_BYTES);
        if (per_cu < 1) { fprintf(stderr, "kernel_launch: occupancy query says %d blocks per CU\n", per_cu); per_cu = 1; }
        grid_blocks = cus;
    }
    if (grid_blocks < 0) return;
    Params p{};
    p.x_prompt = (const float*)d_in[0]; p.x_sample = (const float*)d_in[1]; p.norm_g = (const float*)d_in[2]; p.w_in = (const float*)d_in[3];
    p.shift_mu = (const float*)d_in[4]; p.w0 = (const float*)d_in[5]; p.w_up = (const float*)d_in[6]; p.a0 = (const float*)d_in[7]; p.a_up = (const float*)d_in[8];
    p.k_k = (const float*)d_in[9]; p.k_a = (const float*)d_in[10]; p.r_k = (const float*)d_in[11]; p.lnx_g = (const float*)d_in[12]; p.lnx_b = (const float*)d_in[13];
    p.q_norm_g = (const float*)d_in[14]; p.k_norm_g = (const float*)d_in[15]; p.rpb = (const float*)d_in[16]; p.w_out = (const float*)d_in[17];
    p.out = (float*)d_out; p.ws = (unsigned char*)d_ws;
    if (hipMemsetAsync((char*)d_ws + WS_CTL, 0, 1u << 20, stream) != hipSuccess) { fprintf(stderr, "kernel_launch: memset of control words failed\n"); return; }
    void* args[] = {&p};
    hipError_t e = hipLaunchCooperativeKernel((void*)fwd_megakernel, dim3(grid_blocks), dim3(NTHREADS), args, LDS_BYTES, stream);
    if (e != hipSuccess) fprintf(stderr, "cooperative launch failed: %s (grid %d)\n", hipGetErrorString(e), grid_blocks);
}
```
